# Optimizing an MI355X kernel written in HIP

```python
import jax, jax.numpy as jnp
from jax import lax
import numpy as np

D_MODEL = 2048
BATCH = 4
SEQ = 4096
DEPTH = 4

HEAD_DIM = 128
N_MIX_HEADS = D_MODEL // HEAD_DIM
N_HEADS_A = 4
N_HEADS_B = 6
N_HEADS_C = 6
DILATED_PATTERNS = ((128, 1), (512, 4), (2048, 16))
C_HEADS_PER_PATTERN = N_HEADS_C // len(DILATED_PATTERNS)
OUT_WIDTH = (N_HEADS_A + N_HEADS_B + C_HEADS_PER_PATTERN) * HEAD_DIM
MOBA_BLOCK = 256
MOBA_TOPK = 3
MOBA_Q_CHUNK = 64
SB_Q_BLOCK = 128
ROPE_THETA = 10000.0
MEM_LEN = 256
CROSS_HEADS = 4
CROSS_HEAD_DIM = 128
D_FF = 4 * D_MODEL
RMS_EPS = 1e-6
NEG_INF = -1e30

kernel_name = "hybrid_moba_stickbreak_dilated_block"


def rms_norm(x, g):
    x32 = x.astype(jnp.float32)
    y = x32 * lax.rsqrt(jnp.mean(x32 * x32, axis=-1, keepdims=True) + RMS_EPS)
    return (y * g.astype(jnp.float32)).astype(x.dtype)


def rope_tables(seq_len):
    inv_freq = 1.0 / (ROPE_THETA ** (jnp.arange(0, HEAD_DIM, 2, dtype=jnp.float32) / HEAD_DIM))
    ang = jnp.arange(seq_len, dtype=jnp.float32)[:, None] * inv_freq[None, :]
    return jnp.cos(ang), jnp.sin(ang)


def apply_rope(x, cos, sin):
    x32 = x.astype(jnp.float32)
    x1, x2 = jnp.split(x32, 2, axis=-1)
    return jnp.concatenate([x1 * cos - x2 * sin, x2 * cos + x1 * sin], axis=-1).astype(x.dtype)


def heads_to_channels(o):
    b, h, s, d = o.shape
    return jnp.transpose(o, (0, 2, 1, 3)).reshape(b, s, h * d)


def moba_attention(q, k, v):
    bsz, nh, seq, dh = q.shape
    scale = dh ** -0.5
    n_blk = -(-seq // MOBA_BLOCK)
    pad = ((0, 0), (0, 0), (0, n_blk * MOBA_BLOCK - seq), (0, 0))
    k_blk = jnp.pad(k, pad).reshape(bsz, nh, n_blk, MOBA_BLOCK, dh)
    v_blk = jnp.pad(v, pad).reshape(bsz, nh, n_blk, MOBA_BLOCK, dh)
    k_mean = jnp.mean(k_blk.astype(jnp.float32), axis=3)
    n_sel = min(MOBA_TOPK, n_blk - 1)
    n_chunk = seq // MOBA_Q_CHUNK
    q_chunks = jnp.moveaxis(q.reshape(bsz, nh, n_chunk, MOBA_Q_CHUNK, dh), 2, 0)
    starts = jnp.arange(n_chunk, dtype=jnp.int32) * MOBA_Q_CHUNK
    b_idx = jnp.arange(bsz)[:, None, None, None]
    h_idx = jnp.arange(nh)[None, :, None, None]
    blk_ids = jnp.arange(n_blk)
    in_blk = jnp.arange(MOBA_BLOCK)
    q_off = jnp.arange(MOBA_Q_CHUNK)

    def one_chunk(args):
        qc, start = args
        own = start // MOBA_BLOCK
        t_q = start + q_off
        k_own = lax.dynamic_index_in_dim(k_blk, own, axis=2, keepdims=False)
        v_own = lax.dynamic_index_in_dim(v_blk, own, axis=2, keepdims=False)
        s_own = jnp.einsum('bhqd,bhnd->bhqn', qc, k_own, preferred_element_type=jnp.float32) * scale
        causal = (own * MOBA_BLOCK + in_blk)[None, :] <= t_q[:, None]
        s_own = jnp.where(causal, s_own, NEG_INF)
        if n_sel == 0:
            p = jax.nn.softmax(s_own, axis=-1).astype(v.dtype)
            return jnp.einsum('bhqn,bhnd->bhqd', p, v_own)
        gate = jnp.einsum('bhqd,bhjd->bhqj', qc.astype(jnp.float32), k_mean)
        gate = jnp.where(blk_ids < own, gate, NEG_INF)
        _, sel = lax.top_k(gate, n_sel)
        sel_valid = sel < own
        k_sel = k_blk[b_idx, h_idx, sel]
        v_sel = v_blk[b_idx, h_idx, sel]
        s_sel = jnp.einsum('bhqd,bhqknd->bhqkn', qc, k_sel, preferred_element_type=jnp.float32) * scale
        s_sel = jnp.where(sel_valid[..., None], s_sel, NEG_INF)
        width = n_sel * MOBA_BLOCK
        scores = jnp.concatenate([s_sel.reshape(bsz, nh, MOBA_Q_CHUNK, width), s_own], axis=-1)
        p = jax.nn.softmax(scores, axis=-1).astype(v.dtype)
        p_sel = p[..., :width].reshape(bsz, nh, MOBA_Q_CHUNK, n_sel, MOBA_BLOCK)
        p_own = p[..., width:]
        return (jnp.einsum('bhqkn,bhqknd->bhqd', p_sel, v_sel)
                + jnp.einsum('bhqn,bhnd->bhqd', p_own, v_own))

    out = lax.map(one_chunk, (q_chunks, starts))
    return jnp.moveaxis(out, 0, 2).reshape(bsz, nh, seq, dh)


def stick_breaking_attention(q, k, v):
    bsz, nh, seq, dh = q.shape
    scale = dh ** -0.5
    outs = []
    for i in range(seq // SB_Q_BLOCK):
        lo, hi = i * SB_Q_BLOCK, (i + 1) * SB_Q_BLOCK
        z = jnp.einsum('bhqd,bhkd->bhqk', q[:, :, lo:hi], k[:, :, :hi],
                       preferred_element_type=jnp.float32) * scale
        past = jnp.arange(hi)[None, :] < jnp.arange(lo, hi)[:, None]
        log_keep = jnp.where(past, jax.nn.log_sigmoid(-z), 0.0)
        log_stick = lax.cumsum(log_keep, axis=3, reverse=True) - log_keep
        w = jnp.where(past, jnp.exp(jax.nn.log_sigmoid(z) + log_stick), 0.0)
        outs.append(jnp.einsum('bhqk,bhkd->bhqd', w.astype(v.dtype), v[:, :, :hi]))
    return jnp.concatenate(outs, axis=2)


def banded_causal_attention(q, k, v, steps):
    bsz, nh, n, dh = q.shape
    scale = dh ** -0.5
    blk = steps
    n_blk = -(-n // blk)
    pad = ((0, 0), (0, 0), (0, n_blk * blk - n), (0, 0))
    qb = jnp.pad(q, pad).reshape(bsz, nh, n_blk, blk, dh)
    kb = jnp.pad(k, pad).reshape(bsz, nh, n_blk, blk, dh)
    vb = jnp.pad(v, pad).reshape(bsz, nh, n_blk, blk, dh)

    def with_prev(xb):
        prev = jnp.concatenate([jnp.zeros_like(xb[:, :, :1]), xb[:, :, :-1]], axis=2)
        return jnp.concatenate([prev, xb], axis=3)

    kk, vv = with_prev(kb), with_prev(vb)
    s = jnp.einsum('bhnqd,bhnkd->bhnqk', qb, kk, preferred_element_type=jnp.float32) * scale
    qi = jnp.arange(blk)[:, None]
    kj = jnp.arange(2 * blk)[None, :]
    dist = qi + blk - kj
    key_pos = jnp.arange(n_blk)[:, None, None] * blk - blk + kj[None]
    mask = (dist >= 0) & (dist <= steps) & (key_pos >= 0)
    s = jnp.where(mask, s, NEG_INF)
    lse = jax.nn.logsumexp(s, axis=-1)
    p = jnp.exp(s - lse[..., None]).astype(v.dtype)
    out = jnp.einsum('bhnqk,bhnkd->bhnqd', p, vv).reshape(bsz, nh, n_blk * blk, dh)[:, :, :n]
    return out, lse.reshape(bsz, nh, n_blk * blk)[:, :, :n]


def dilated_attention(q, k, v, window, dilation):
    bsz, nh, seq, dh = q.shape
    sub = seq // dilation

    def split(x):
        return jnp.transpose(x.reshape(bsz, nh, sub, dilation, dh), (0, 1, 3, 2, 4)).reshape(bsz, nh * dilation, sub, dh)

    out, lse = banded_causal_attention(split(q), split(k), split(v), window // dilation)
    out = jnp.transpose(out.reshape(bsz, nh, dilation, sub, dh), (0, 1, 3, 2, 4)).reshape(bsz, nh, seq, dh)
    lse = jnp.transpose(lse.reshape(bsz, nh, dilation, sub), (0, 1, 3, 2)).reshape(bsz, nh, seq)
    return out, lse


def dilated_mixture(q, k, v):
    outs, lses = [], []
    for g, (window, dilation) in enumerate(DILATED_PATTERNS):
        sl = slice(g * C_HEADS_PER_PATTERN, (g + 1) * C_HEADS_PER_PATTERN)
        o, l = dilated_attention(q[:, sl], k[:, sl], v[:, sl], window, dilation)
        outs.append(o)
        lses.append(l)
    alpha = jax.nn.softmax(jnp.stack(lses, axis=0), axis=0)
    mixed = jnp.sum(alpha[..., None] * jnp.stack(outs, axis=0).astype(jnp.float32), axis=0)
    return mixed.astype(v.dtype)


def cross_attention(h, mem_n, w_q, w_kv, w_o):
    bsz, seq, _ = h.shape
    m = mem_n.shape[1]
    q = jnp.einsum('bsd,de->bse', h, w_q).reshape(bsz, seq, CROSS_HEADS, CROSS_HEAD_DIM)
    kv = jnp.einsum('bmd,de->bme', mem_n, w_kv).reshape(bsz, m, 2, CROSS_HEADS, CROSS_HEAD_DIM)
    s = jnp.einsum('bshd,bmhd->bhsm', q, kv[:, :, 0], preferred_element_type=jnp.float32) * CROSS_HEAD_DIM ** -0.5
    p = jax.nn.softmax(s, axis=-1).astype(h.dtype)
    o = jnp.einsum('bhsm,bmhd->bshd', p, kv[:, :, 1]).reshape(bsz, seq, CROSS_HEADS * CROSS_HEAD_DIM)
    return jnp.einsum('bse,ed->bsd', o, w_o)


def setup_inputs(seed: int = 0) -> dict:
    key = jax.random.key(seed)
    ks = jax.random.split(key, 17)
    f32 = jnp.float32

    def nrm(k, shape, scale):
        return jax.random.normal(k, shape, f32) * scale

    def gain(k, shape):
        return 1.0 + 0.02 * jax.random.normal(k, shape, f32)

    cw = CROSS_HEADS * CROSS_HEAD_DIM
    return {
        "x": nrm(ks[0], (BATCH, SEQ, D_MODEL), 1.0),
        "mem": nrm(ks[1], (BATCH, MEM_LEN, D_MODEL), 1.0),
        "g_mix": gain(ks[2], (DEPTH, D_MODEL)),
        "w_in": nrm(ks[3], (DEPTH, D_MODEL, 3 * N_MIX_HEADS * HEAD_DIM), D_MODEL ** -0.5),
        "g_out_a": gain(ks[4], (DEPTH, N_HEADS_A * HEAD_DIM)),
        "g_out_b": gain(ks[5], (DEPTH, N_HEADS_B * HEAD_DIM)),
        "g_out_c": gain(ks[6], (DEPTH, C_HEADS_PER_PATTERN * HEAD_DIM)),
        "w_out": nrm(ks[7], (DEPTH, OUT_WIDTH, D_MODEL), OUT_WIDTH ** -0.5),
        "g_cross": gain(ks[8], (DEPTH, D_MODEL)),
        "g_mem": gain(ks[9], (D_MODEL,)),
        "w_cq": nrm(ks[10], (DEPTH, D_MODEL, cw), D_MODEL ** -0.5),
        "w_ckv": nrm(ks[11], (DEPTH, D_MODEL, 2 * cw), D_MODEL ** -0.5),
        "w_co": nrm(ks[12], (DEPTH, cw, D_MODEL), cw ** -0.5),
        "g_mlp": gain(ks[13], (DEPTH, D_MODEL)),
        "w_up": nrm(ks[14], (DEPTH, D_MODEL, D_FF), D_MODEL ** -0.5),
        "w_down": nrm(ks[15], (DEPTH, D_FF, D_MODEL), D_FF ** -0.5),
        "g_final": gain(ks[16], (D_MODEL,)),
    }


def reference(x, mem, g_mix, w_in, g_out_a, g_out_b, g_out_c, w_out, g_cross, g_mem,
              w_cq, w_ckv, w_co, g_mlp, w_up, w_down, g_final):
    bsz, seq, _ = x.shape
    cos, sin = rope_tables(seq)
    mem_n = rms_norm(mem, g_mem)
    ha, hb = N_HEADS_A, N_HEADS_A + N_HEADS_B
    for l in range(DEPTH):
        h = rms_norm(x, g_mix[l])
        qkv = jnp.einsum('bsd,de->bse', h, w_in[l]).reshape(bsz, seq, 3, N_MIX_HEADS, HEAD_DIM)
        q = jnp.transpose(qkv[:, :, 0], (0, 2, 1, 3))
        k = jnp.transpose(qkv[:, :, 1], (0, 2, 1, 3))
        v = jnp.transpose(qkv[:, :, 2], (0, 2, 1, 3))
        o_a = moba_attention(apply_rope(q[:, :ha], cos, sin), apply_rope(k[:, :ha], cos, sin), v[:, :ha])
        o_b = stick_breaking_attention(q[:, ha:hb], k[:, ha:hb], v[:, ha:hb])
        o_c = dilated_mixture(apply_rope(q[:, hb:], cos, sin), apply_rope(k[:, hb:], cos, sin), v[:, hb:])
        merged = jnp.concatenate([
            rms_norm(heads_to_channels(o_a), g_out_a[l]),
            rms_norm(heads_to_channels(o_b), g_out_b[l]),
            rms_norm(heads_to_channels(o_c), g_out_c[l]),
        ], axis=-1)
        x = x + jnp.einsum('bse,ed->bsd', merged, w_out[l])
        x = x + cross_attention(rms_norm(x, g_cross[l]), mem_n, w_cq[l], w_ckv[l], w_co[l])
        u = jnp.einsum('bsd,df->bsf', rms_norm(x, g_mlp[l]), w_up[l])
        x = x + jnp.einsum('bsf,fd->bsd', jnp.square(jax.nn.relu(u)), w_down[l])
    return rms_norm(x, g_final)
```

```cpp
#include <hip/hip_runtime.h>
#include <cstdio>
#include <cstdint>

constexpr int DM = 2048, BATCH = 4, SEQ = 4096, DEPTH = 4, HD = 128, NH = 16;
constexpr int M = BATCH * SEQ;
constexpr int NQKV = 3 * DM, OW = 1536, CW = 512, FF = 8192, MEML = 256, MROWS = BATCH * MEML;
constexpr float EPS = 1e-6f;
#ifndef MLP_FP8
#define MLP_FP8 1
#endif
#ifndef V_FP8
#define V_FP8 1
#endif
constexpr float W8_V_SCALE = 64.f, W8_CQ_SCALE = 64.f;
#ifndef CO_FP8
#define CO_FP8 1
#endif
constexpr float W8_CO_SCALE = 32.f;
#ifndef CQ_FP8
#define CQ_FP8 1
#endif
#ifndef MOBA_GATHER
#define MOBA_GATHER 1
#endif
#ifndef OUT_I8
#define OUT_I8 1
#endif
constexpr float W8_UP_SCALE = 64.f, W8_DN_SCALE = 128.f;
constexpr float C2 = 0.08838834764831845f * 1.4426950408889634f;

constexpr size_t MiB = 1u << 20;
constexpr size_t WS_CTL = 0, CTL_ZERO_BYTES = 64 * 1024;
constexpr size_t WS_WIN = 1 * MiB, WS_WOUT = 97 * MiB, WS_WCQ = 121 * MiB, WS_WCO = 129 * MiB, WS_WUP = 137 * MiB, WS_WDN = 265 * MiB, WS_WCKV = 393 * MiB;
constexpr size_t WS_MEMN = 409 * MiB, WS_CK = 413 * MiB, WS_CV = 417 * MiB, WS_ROPE = 421 * MiB, WS_SSP = 423 * MiB, WS_KMP = 425 * MiB, WS_LSE = 426 * MiB;
constexpr size_t WS_XB = 427 * MiB, WS_MRG = 491 * MiB, WS_QC = 539 * MiB, WS_OCR = 555 * MiB, WS_R1 = 571 * MiB, WS_XB8 = 827 * MiB, WS_WV8 = 859 * MiB, WS_RSC = 875 * MiB, WS_CSC = WS_RSC + 64 * 1024, WS_PART = 876 * MiB, WS_PLSE = 940 * MiB, WS_SEL = 941 * MiB, WS_CNT = WS_SEL + 512 * 1024, WS_LIST = 942 * MiB, WS_END = 944 * MiB;
constexpr size_t WS_Q = WS_R1, WS_K = WS_R1 + 64 * MiB, WS_V = WS_R1 + 128 * MiB, WS_OA = WS_R1 + 192 * MiB, WS_OB = WS_R1 + 208 * MiB, WS_OC = WS_R1 + 232 * MiB, WS_ACT = WS_R1;

constexpr int PH_PRO0 = 0, PH_PRO1 = 1, PH_L0 = 2, PH_PER_LAYER = 10, PH_FINAL = PH_L0 + PH_PER_LAYER * DEPTH, NPH = PH_FINAL + 1;
enum { LP_QKV = 0, LP_KM = 1, LP_ATT = 2, LP_MRG = 3, LP_OUT = 4, LP_CQ = 5, LP_XATT = 6, LP_CO = 7, LP_UP = 8, LP_DN = 9 };

constexpr int NWAVES = 8, NTHREADS = 512;
constexpr int LDS_BYTES = 147456, MISC_OFF = 131072 + 1024;
constexpr int CW_BAR = 4096;

#define GAS __attribute__((address_space(1)))
#define LAS __attribute__((address_space(3)))
typedef unsigned short bf16;
typedef unsigned u32x4 __attribute__((ext_vector_type(4)));
typedef unsigned u32x2 __attribute__((ext_vector_type(2)));
typedef float f32x4 __attribute__((ext_vector_type(4)));
typedef short bf16x8 __attribute__((ext_vector_type(8)));
#define LDS_WAIT() asm volatile("s_waitcnt lgkmcnt(0)" ::: "memory")

__device__ __forceinline__ unsigned f2bf(float f) { unsigned u = __builtin_bit_cast(unsigned, f); return (u + 0x7fffu + ((u >> 16) & 1u)) >> 16; }
__device__ __forceinline__ unsigned pk2(float lo, float hi) { return f2bf(lo) | (f2bf(hi) << 16); }
__device__ __forceinline__ float bflo(unsigned w) { return __builtin_bit_cast(float, w << 16); }
__device__ __forceinline__ float bfhi(unsigned w) { return __builtin_bit_cast(float, w & 0xffff0000u); }
template <int X> __device__ __forceinline__ float xor_lane(float v) { return __builtin_bit_cast(float, __builtin_amdgcn_ds_swizzle(__builtin_bit_cast(int, v), (X << 10) | 0x1F)); }
__device__ __forceinline__ float sum_xor32(float v) { float w = v; asm volatile("" : "+v"(w));   auto rr = __builtin_amdgcn_permlane32_swap(__builtin_bit_cast(unsigned, v), __builtin_bit_cast(unsigned, w), false, false); return __builtin_bit_cast(float, rr[0]) + __builtin_bit_cast(float, rr[1]); }
__device__ __forceinline__ float max_xor32(float v) { float w = v; asm volatile("" : "+v"(w)); auto rr = __builtin_amdgcn_permlane32_swap(__builtin_bit_cast(unsigned, v), __builtin_bit_cast(unsigned, w), false, false); return fmaxf(__builtin_bit_cast(float, rr[0]), __builtin_bit_cast(float, rr[1])); }
__device__ __forceinline__ float get_xor32(float v, int hi) { float w = v; asm volatile("" : "+v"(w)); auto rr = __builtin_amdgcn_permlane32_swap(__builtin_bit_cast(unsigned, v), __builtin_bit_cast(unsigned, w), false, false); return __builtin_bit_cast(float, hi ? rr[0] : rr[1]); }
__device__ __forceinline__ float rdlane(float v, int l) { return __builtin_bit_cast(float, __builtin_amdgcn_readlane(__builtin_bit_cast(int, v), l)); }
__device__ __forceinline__ unsigned pk4i8(float a, float b, float c, float d) {
    const int ia = (int)rintf(a) & 255, ib = (int)rintf(b) & 255, ic = (int)rintf(c) & 255, id = (int)rintf(d) & 255;
    return (unsigned)(ia | (ib << 8) | (ic << 16) | (id << 24)); }
__device__ __forceinline__ float wave_sum(float v) { v += xor_lane<1>(v); v += xor_lane<2>(v); v += xor_lane<4>(v); v += xor_lane<8>(v); v += xor_lane<16>(v); return rdlane(v, 0) + rdlane(v, 32); }
__device__ __forceinline__ float wave_max(float v) { v = fmaxf(v, xor_lane<1>(v)); v = fmaxf(v, xor_lane<2>(v)); v = fmaxf(v, xor_lane<4>(v)); v = fmaxf(v, xor_lane<8>(v)); v = fmaxf(v, xor_lane<16>(v)); return fmaxf(rdlane(v, 0), rdlane(v, 32)); }
__device__ __forceinline__ unsigned pk4f8(float a, float b, float c, float d) { int p = __builtin_amdgcn_cvt_pk_fp8_f32(a, b, 0, false); p = __builtin_amdgcn_cvt_pk_fp8_f32(c, d, p, true); return (unsigned)p; }
__device__ __forceinline__ int lane_id() { int r; asm volatile("v_mbcnt_lo_u32_b32 %0, -1, 0\n\tv_mbcnt_hi_u32_b32 %0, -1, %0" : "=v"(r)); return r; }
__device__ __forceinline__ float ex2(float x) { return __builtin_amdgcn_exp2f(x); }
__device__ __forceinline__ float lg2(float x) { return __builtin_amdgcn_logf(x); }
__device__ __forceinline__ float rstd_from_ssp(const float* ssp, int row, float invn) {
    const f32x4* p = (const f32x4*)(ssp + (size_t)row * 32); float s = 0.f;
#pragma unroll
    for (int i = 0; i < 8; ++i) { const f32x4 v = p[i]; s += (v.x + v.y) + (v.z + v.w); }
    return 1.0f / sqrtf(s * invn + EPS);
}

namespace pg8 {
#define PG8_LAS __attribute__((address_space(3)))
typedef unsigned short bf16_t;
typedef short bf16x8 __attribute__((ext_vector_type(8)));
typedef float f32x4 __attribute__((ext_vector_type(4)));
typedef unsigned u32x4 __attribute__((ext_vector_type(4)));
typedef int v4i_t __attribute__((ext_vector_type(4)));
constexpr int BM = 256, BK = 64, HALF = 128, HTB = HALF * BK * 2  , STAGE_BYTES = 8 * HTB, NXCD = 8, WGM = 8;

__host__ __device__ __forceinline__ int lds_byte(int r, int c) { const int st = (r >> 4) * 2 + (c >> 5), rr = r & 15, cc = c & 31, ob = rr * 64 + cc * 2; return st * 1024 + (ob ^ (((ob >> 9) & 1) << 5)); }
__host__ __device__ __forceinline__ void stage_rc(int b, int& R, int& C) { const int st = b / 1024, sb = b % 1024, swz = sb ^ (((sb >> 9) & 1) << 5); R = (st >> 1) * 16 + swz / 64; C = (st & 1) * 32 + (swz % 64) / 2; }
__host__ __device__ __forceinline__ int perm32(int rho) { const int n = rho >> 4, i = rho & 15; return 8 * (i >> 2) + 4 * n + (i & 3); }

struct Unit { int pm, pn, idx; };
struct Gemm { const bf16_t* A; const bf16_t* Bt; int M, N, K; };

struct StaticOrder {
    int nM, nN, nwg, G, c;
    __host__ __device__ void init(int M, int N, int G_, int c_) { nM = M / BM; nN = N / BM; nwg = nM * nN; G = G_; c = c_; }
    __host__ __device__ bool next(int i, Unit& u) const {
        const long L = (long)i * G + c; if (L >= nwg) return false;
        int wgid = (int)L; { const int q = nwg / NXCD, r = nwg % NXCD, xcd = wgid % NXCD, off = wgid / NXCD; wgid = (xcd < r ? xcd * (q + 1) : r * (q + 1) + (xcd - r) * q) + off; }
        const int nig = WGM * nN, gid = wgid / nig, fm = gid * WGM, gsz = (nM - fm) < WGM ? (nM - fm) : WGM;
        u.pm = fm + ((wgid % nig) % gsz); u.pn = (wgid % nig) / gsz; u.idx = i; return true;
    }
    __device__ __forceinline__ void a_ready(const Unit&) const {}
    __device__ __forceinline__ void done(const Unit&) const {}
};
struct OneUnit { int pm, pn;
    __device__ __forceinline__ bool next(int i, Unit& u) const { if (i) return false; u.pm = pm; u.pn = pn; u.idx = 0; return true; }
    __device__ __forceinline__ void a_ready(const Unit&) const {}
    __device__ __forceinline__ void done(const Unit&) const {}
};

__device__ __forceinline__ unsigned cvt_pk_bf16(float lo, float hi) { unsigned r; asm volatile("v_cvt_pk_bf16_f32 %0, %1, %2" : "=v"(r) : "v"(lo), "v"(hi)); return r; }
template <class Epi, class Sched, bool ALIGN_EPI = false, bool SP2 = false, int F8 = 0>
__device__ __forceinline__ void gemm_phase(PG8_LAS unsigned char* lds, const Gemm g, const Sched& S, const Epi& E, const int wid_in) {
    int wid = wid_in; asm volatile("" : "+s"(wid));
    const int lane_ = lane_id();
    const int lane = lane_, tid = wid * 64 + lane, wr = wid >> 2, wc = wid & 3, fr = lane & 15, fq = lane >> 4;
    const int Kb = F8 ? g.K : 2 * g.K, nt = Kb / (2 * BK);
    unsigned voffA[2], voffB[2];
#pragma unroll
    for (int i = 0; i < 2; ++i) { int R, C; stage_rc(tid * 16 + i * 8192, R, C); const int Rb = Epi::PERM ? ((R & ~31) + perm32(R & 31)) : R;
        voffA[i] = (unsigned)(R * Kb + C * 2); voffB[i] = (unsigned)(Rb * Kb + C * 2); }
    const size_t kstep = (size_t)(BK * 2);
    const size_t hstep = (size_t)HALF * Kb;
    const size_t tstep = 2 * hstep;
    const unsigned ldsb = (unsigned)(size_t)lds + (unsigned)wid * 1024u;
    const unsigned ldsw = (unsigned)wid * 1024u;
    const int aoff = lds_byte(wr * 64 + fr, fq * 8), boff = lds_byte(wc * 32 + fr, fq * 8);
#define PG8_SA(b, h) (((b) * 2 + (h)) * HTB)
#define PG8_SB(b, h) ((4 + (b) * 2 + (h)) * HTB)
#define PG8_STAGE(bufoff, gbase, voff) do { _Pragma("unroll") for (int _i = 0; _i < 2; ++_i) { \
        asm volatile("s_mov_b32 m0, %2\n\ts_nop 0\n\tglobal_load_lds_dwordx4 %0, %1" :: "v"((voff)[_i]), "s"((const char*)(gbase)), "s"(ldsb + (unsigned)((bufoff) + _i * 8192)) : "memory", "m0"); } } while (0)
#define PG8_LDA(dst, b, h) do { _Pragma("unroll") for (int m = 0; m < 4; ++m) _Pragma("unroll") for (int k = 0; k < 2; ++k) dst[m][k] = *(const PG8_LAS bf16x8*)(lds + PG8_SA(b, h) + aoff + m * 2048 + k * 1024); } while (0)
#define PG8_LDB(dst, b, h) do { _Pragma("unroll") for (int n = 0; n < 2; ++n) _Pragma("unroll") for (int k = 0; k < 2; ++k) dst[n][k] = *(const PG8_LAS bf16x8*)(lds + PG8_SB(b, h) + boff + n * 2048 + k * 1024); } while (0)
#define PG8_CAT(x0, x1) __builtin_shufflevector(__builtin_bit_cast(v4i_t, x0), __builtin_bit_cast(v4i_t, x1), 0, 1, 2, 3, 4, 5, 6, 7)
#define PG8_MMA(ai, bj, At, Bt) do { __builtin_amdgcn_s_setprio(1); _Pragma("unroll") for (int m = 0; m < 4; ++m) _Pragma("unroll") for (int n = 0; n < 2; ++n) { \
        if constexpr (F8 == 1) asm volatile("s_nop 1\n\tv_mfma_scale_f32_16x16x128_f8f6f4 %0, %1, %2, %0, %3, %3 op_sel_hi:[0,0,0]" : "+v"(acc[ai][bj][m][n]) : "v"(PG8_CAT(Bt[n][0], Bt[n][1])), "v"(PG8_CAT(At[m][0], At[m][1])), "v"(scale1_));   \
        else if constexpr (F8 == 2) { _Pragma("unroll") for (int k = 0; k < 2; ++k) acc[ai][bj][m][n] = __builtin_bit_cast(f32x4, __builtin_amdgcn_mfma_i32_16x16x64_i8(__builtin_bit_cast(v4i_t, Bt[n][k]), __builtin_bit_cast(v4i_t, At[m][k]), __builtin_bit_cast(v4i_t, acc[ai][bj][m][n]), 0, 0, 0)); } \
        else { _Pragma("unroll") for (int k = 0; k < 2; ++k) acc[ai][bj][m][n] = __builtin_amdgcn_mfma_f32_16x16x32_bf16(Bt[n][k], At[m][k], acc[ai][bj][m][n], 0, 0, 0); } } \
        __builtin_amdgcn_s_setprio(0); } while (0)
#define PG8_WAIT_V(n) asm volatile("s_waitcnt vmcnt(" #n ")" ::: "memory")
#define PG8_WAIT_L(n) asm volatile("s_waitcnt lgkmcnt(" #n ")" ::: "memory")
#define PG8_BAR __builtin_amdgcn_s_barrier()
#define PG8_SCHED __builtin_amdgcn_sched_barrier(0)
    Unit cur, nxt; int ui = 0;
    if (!S.next(0, cur)) return;
    f32x4 acc[2][2][4][2];
    int scale1_ = 0x7f7f7f7f; asm volatile("" : "+v"(scale1_));
    float zero_ = 0.f; asm volatile("" : "+v"(zero_));
#pragma unroll
    for (int a = 0; a < 2; ++a)
#pragma unroll
        for (int b = 0; b < 2; ++b)
#pragma unroll
            for (int m = 0; m < 4; ++m)
#pragma unroll
                for (int n = 0; n < 2; ++n) acc[a][b][m][n] = (f32x4){zero_, zero_, zero_, zero_};
    bf16x8 At[4][2], B0[2][2], B1[2][2];
    const char* cA = (const char*)g.A + (size_t)cur.pm * tstep; const char* cB = (const char*)g.Bt + (size_t)cur.pn * tstep;
    S.a_ready(cur);
    if constexpr (SP2) {
        PG8_STAGE(PG8_SB(0, 0), cB, voffB); PG8_STAGE(PG8_SB(0, 1), cB + hstep, voffB); PG8_STAGE(PG8_SA(0, 0), cA, voffA); PG8_STAGE(PG8_SA(0, 1), cA + hstep, voffA);
        if (wr == 1) PG8_BAR;
        PG8_WAIT_V(2); PG8_BAR;
        PG8_STAGE(PG8_SB(1, 0), cB + kstep, voffB); PG8_STAGE(PG8_SA(1, 0), cA + kstep, voffA); PG8_STAGE(PG8_SB(1, 1), cB + hstep + kstep, voffB);
        PG8_WAIT_V(6); PG8_BAR;
    } else {
        PG8_STAGE(PG8_SB(0, 0), cB, voffB); PG8_STAGE(PG8_SA(0, 0), cA, voffA); PG8_STAGE(PG8_SB(0, 1), cB + hstep, voffB); PG8_STAGE(PG8_SA(0, 1), cA + hstep, voffA);
        if (wr == 1) PG8_BAR;
        PG8_WAIT_V(4); PG8_BAR;
        PG8_STAGE(PG8_SB(1, 0), cB + kstep, voffB); PG8_STAGE(PG8_SA(1, 0), cA + kstep, voffA); PG8_STAGE(PG8_SB(1, 1), cB + hstep + kstep, voffB);
        PG8_WAIT_V(6); PG8_BAR;
    }
    for (;;) {
        const bool has_next = S.next(ui + 1, nxt);
        const char* nA = has_next ? (const char*)g.A + (size_t)nxt.pm * tstep : cA; const char* nB = has_next ? (const char*)g.Bt + (size_t)nxt.pn * tstep : cB;
        for (int t = 0; t < nt; t += 2) {
            const bool last = (t == nt - 2);
            const char* a1 = cA + (size_t)(t + 1) * kstep;
            const char* a2 = last ? nA : cA + (size_t)(t + 2) * kstep; const char* b2 = last ? nB : cB + (size_t)(t + 2) * kstep;
            const char* a3 = a2 + kstep; const char* b3 = b2 + kstep;
            if (last && has_next) S.a_ready(nxt);
            if constexpr (SP2) {
            PG8_LDB(B0, 0, 0); PG8_LDB(B1, 0, 1); PG8_SCHED; PG8_LDA(At, 0, 0); PG8_STAGE(PG8_SA(1, 1), a1 + hstep, voffA);
            PG8_WAIT_V(8); PG8_WAIT_L(0); PG8_BAR; PG8_MMA(0, 0, At, B0); PG8_MMA(0, 1, At, B1); PG8_BAR; PG8_SCHED;
            PG8_LDA(At, 0, 1); PG8_STAGE(PG8_SB(0, 0), b2, voffB); PG8_STAGE(PG8_SB(0, 1), b2 + hstep, voffB); PG8_STAGE(PG8_SA(0, 0), a2, voffA);
            PG8_WAIT_V(8); PG8_WAIT_L(0); PG8_BAR; PG8_MMA(1, 0, At, B0); PG8_MMA(1, 1, At, B1); PG8_BAR; PG8_SCHED;
            PG8_LDB(B0, 1, 0); PG8_LDB(B1, 1, 1); PG8_SCHED; PG8_LDA(At, 1, 0); PG8_STAGE(PG8_SA(0, 1), a2 + hstep, voffA);
            PG8_WAIT_V(8); PG8_WAIT_L(0); PG8_BAR; PG8_MMA(0, 0, At, B0); PG8_MMA(0, 1, At, B1); PG8_BAR; PG8_SCHED;
            PG8_LDA(At, 1, 1); PG8_STAGE(PG8_SB(1, 0), b3, voffB); PG8_STAGE(PG8_SB(1, 1), b3 + hstep, voffB); PG8_STAGE(PG8_SA(1, 0), a3, voffA);
            PG8_WAIT_V(8); PG8_WAIT_L(0); PG8_BAR; PG8_MMA(1, 0, At, B0); PG8_MMA(1, 1, At, B1); PG8_BAR; PG8_SCHED;
            } else {
            PG8_LDB(B0, 0, 0); PG8_SCHED; PG8_LDA(At, 0, 0); PG8_STAGE(PG8_SA(1, 1), a1 + hstep, voffA);
            PG8_WAIT_L(8); PG8_BAR; PG8_WAIT_L(0); PG8_MMA(0, 0, At, B0); PG8_BAR; PG8_SCHED;
            PG8_LDB(B1, 0, 1); PG8_STAGE(PG8_SB(0, 0), b2, voffB);
            PG8_BAR; PG8_WAIT_L(0); PG8_MMA(0, 1, At, B1); PG8_BAR;
            PG8_LDA(At, 0, 1); PG8_STAGE(PG8_SA(0, 0), a2, voffA);
            PG8_BAR; PG8_WAIT_L(0); PG8_MMA(1, 0, At, B0); PG8_BAR; PG8_SCHED;
            PG8_STAGE(PG8_SB(0, 1), b2 + hstep, voffB);
            PG8_WAIT_V(6); PG8_BAR; PG8_MMA(1, 1, At, B1); PG8_BAR;
            PG8_LDB(B0, 1, 0); PG8_SCHED; PG8_LDA(At, 1, 0); PG8_STAGE(PG8_SA(0, 1), a2 + hstep, voffA);
            PG8_WAIT_L(8); PG8_BAR; PG8_WAIT_L(0); PG8_MMA(0, 0, At, B0); PG8_BAR; PG8_SCHED;
            PG8_LDB(B1, 1, 1); PG8_STAGE(PG8_SB(1, 0), b3, voffB);
            PG8_BAR; PG8_WAIT_L(0); PG8_MMA(0, 1, At, B1); PG8_BAR;
            PG8_LDA(At, 1, 1); PG8_STAGE(PG8_SA(1, 0), a3, voffA);
            PG8_BAR; PG8_WAIT_L(0); PG8_MMA(1, 0, At, B0); PG8_BAR; PG8_SCHED;
            PG8_STAGE(PG8_SB(1, 1), b3 + hstep, voffB);
            PG8_WAIT_V(6); PG8_BAR; PG8_MMA(1, 1, At, B1); PG8_BAR;
            }
        }
        if constexpr (ALIGN_EPI) { if (wr == 0) PG8_BAR; }
        if constexpr (F8 == 1) asm volatile("s_nop 15\n\ts_nop 15" ::: "memory");
        if constexpr (!Epi::AFTER_DRAIN) { E(acc, cur, wr, wc, fr, fq); S.done(cur); }
        if (!has_next) break;
#pragma unroll
        for (int a = 0; a < 2; ++a)
#pragma unroll
            for (int b = 0; b < 2; ++b)
#pragma unroll
                for (int m = 0; m < 4; ++m)
#pragma unroll
                    for (int n = 0; n < 2; ++n) acc[a][b][m][n] = (f32x4){zero_, zero_, zero_, zero_};
        cur = nxt; cA = nA; cB = nB; ++ui;
        if constexpr (ALIGN_EPI) { if (wr == 1) PG8_BAR; }
    }
    PG8_WAIT_V(0);
    if constexpr (!ALIGN_EPI) { if (wr == 0) PG8_BAR; }
    PG8_BAR;
    if constexpr (Epi::AFTER_DRAIN) { E.fused(acc, cur, wr, wc, fr, fq, lds, wid, lane); S.done(cur); }
#undef PG8_SA
#undef PG8_SB
#undef PG8_STAGE
#undef PG8_LDA
#undef PG8_LDB
#undef PG8_MMA
#undef PG8_CAT
#undef PG8_WAIT_V
#undef PG8_WAIT_L
#undef PG8_BAR
#undef PG8_SCHED
}
}

constexpr size_t XB8_DELTA = WS_XB8 - WS_XB;
namespace pg8 {
typedef unsigned u32x2e __attribute__((ext_vector_type(2)));
__device__ __forceinline__ u32x4 pack8(const f32x4 a, const f32x4 b) { u32x4 w; w.x = cvt_pk_bf16(a[0], a[1]); w.y = cvt_pk_bf16(a[2], a[3]); w.z = cvt_pk_bf16(b[0], b[1]); w.w = cvt_pk_bf16(b[2], b[3]); return w; }
constexpr int RTAB_OFF = 133120, RTAB_UNITS = 8;
template <class Sched>
__device__ __forceinline__ void rstd_table(PG8_LAS unsigned char* lds, const float* ssp, const Sched& S, int wid) {
    const int t = wid * 64 + lane_id(); PG8_LAS float* tab = (PG8_LAS float*)(lds + RTAB_OFF);
    Unit u; int prev_pm = -1; float val = 0.f;
#pragma unroll 1
    for (int i = 0; i < RTAB_UNITS && S.next(i, u); ++i) {
        if (u.pm != prev_pm) { const f32x4* p = (const f32x4*)(ssp + (size_t)(u.pm * BM + (t >> 1)) * 32 + (t & 1) * 16); float s = 0.f;
#pragma unroll
            for (int j = 0; j < 4; ++j) { const f32x4 a = p[j]; s += (a[0] + a[1]) + (a[2] + a[3]); }
            s += xor_lane<1>(s);
            val = 1.0f / sqrtf(s * (1.0f / 2048.0f) + 1e-6f); prev_pm = u.pm; }
        if ((t & 1) == 0) tab[i * 256 + (t >> 1)] = val; }
    __syncthreads();
}
__device__ __forceinline__ void rstd8(const PG8_LAS float* tab, const Unit& u, int wr, int fr, float (&rs)[2][4]) {
#pragma unroll
    for (int ai = 0; ai < 2; ++ai)
#pragma unroll
        for (int m = 0; m < 4; ++m) rs[ai][m] = tab[u.idx * 256 + ai * HALF + wr * 64 + m * 16 + fr];
}
struct EpiQKV {
    static constexpr bool PERM = true, AFTER_DRAIN = false;
    const PG8_LAS float* rtab; const float* cosT; const float* sinT; bf16_t* Q; size_t tstride; float* KMP; float qscale; int tbase; float vsc;
    __device__ __forceinline__ void operator()(const f32x4 (&acc)[2][2][4][2], const Unit& u, int wr, int wc, int, int) const {
        const int t_ = lane_id(), fr = t_ & 15, fq = t_ >> 4;
        const int row0 = u.pm * BM + wr * 64 + fr, t = tbase + (u.pn >> 3), hp = (u.pn & 7) * 2, b = u.pm >> 4, p0 = wc * 32 + 8 * fq;
        float rs[2][4]; rstd8(rtab, u, wr, fr, rs);
        const bool rope = t < 2 && (hp < 4 || hp >= 10);
        const float sc = t == 0 ? qscale : (t == 2 ? vsc : 1.f);
        bf16_t* base = Q + (size_t)t * tstride;
        f32x4 cs[2][2] = {{(f32x4){0.f, 0.f, 0.f, 0.f}, (f32x4){0.f, 0.f, 0.f, 0.f}}, {(f32x4){0.f, 0.f, 0.f, 0.f}, (f32x4){0.f, 0.f, 0.f, 0.f}}};
        const bool kmean = t == 1 && hp < 4;
#pragma unroll
        for (int ai = 0; ai < 2; ++ai)
#pragma unroll
            for (int m = 0; m < 4; ++m) { const int s = (row0 + ai * HALF + m * 16) & 4095; const float r = rs[ai][m] * sc;
                if (rope) { const f32x4 c = *(const f32x4*)(cosT + s * 64 + (p0 >> 1)), sn = *(const f32x4*)(sinT + s * 64 + (p0 >> 1));
#pragma unroll
                    for (int bj = 0; bj < 2; ++bj) { const f32x4 x1 = acc[ai][bj][m][0] * r, x2 = acc[ai][bj][m][1] * r; const f32x4 o1 = x1 * c - x2 * sn, o2 = x2 * c + x1 * sn;
                        if (kmean) { cs[bj][0] += o1; cs[bj][1] += o2; }
                        *(u32x4*)(base + (((size_t)(b * 16 + hp + bj) * 4096 + s) * 128 + p0)) = pack8(o1, o2); } }
                else {
#pragma unroll
                    for (int bj = 0; bj < 2; ++bj) *(u32x4*)(base + (((size_t)(b * 16 + hp + bj) * 4096 + s) * 128 + p0)) = pack8(acc[ai][bj][m][0] * r, acc[ai][bj][m][1] * r); }
                if (m & 1) asm volatile("" ::: "memory"); }
        if (kmean) {
#pragma unroll
            for (int bj = 0; bj < 2; ++bj)
#pragma unroll
                for (int n = 0; n < 2; ++n)
#pragma unroll
                    for (int i = 0; i < 4; ++i) { float v = cs[bj][n][i]; v += xor_lane<1>(v); v += xor_lane<2>(v); v += xor_lane<4>(v); v += xor_lane<8>(v); cs[bj][n][i] = v; }
            if (fr == 0) {
#pragma unroll
                for (int bj = 0; bj < 2; ++bj) { float* kp = KMP + ((size_t)(((b * 4 + hp + bj) * 16 + (u.pm & 15)) * 2 + wr)) * 128 + p0; *(f32x4*)kp = cs[bj][0]; *(f32x4*)(kp + 4) = cs[bj][1]; } }
        }
    }
};
template <int INV_SCALE, bool W8> struct EpiRes {
    static constexpr bool PERM = true, AFTER_DRAIN = false; static constexpr float scale = 1.0f / INV_SCALE;
    bf16_t* XB; float* ssp;
    __device__ __forceinline__ void operator()(const f32x4 (&acc)[2][2][4][2], const Unit& u, int wr, int wc, int, int) const {
        const int t_ = lane_id(), fr = t_ & 15, fq = t_ >> 4;
        const int row0 = u.pm * BM + wr * 64 + fr, col0 = u.pn * BM + wc * 32 + 8 * fq;
#pragma unroll
        for (int ai = 0; ai < 2; ++ai) {
            u32x4 xw[4][2];
#pragma unroll
            for (int m = 0; m < 4; ++m)
#pragma unroll
                for (int bj = 0; bj < 2; ++bj) xw[m][bj] = *(const u32x4*)(XB + (size_t)(row0 + ai * HALF + m * 16) * 2048 + col0 + bj * HALF);
            asm volatile("" ::: "memory");
#pragma unroll
            for (int m = 0; m < 4; ++m) { const int row = row0 + ai * HALF + m * 16; const size_t off = (size_t)row * 2048 + col0; float ss = 0.f;
#pragma unroll
                for (int bj = 0; bj < 2; ++bj) { const u32x4 w = xw[m][bj];
                    f32x4 a = (f32x4){__builtin_bit_cast(float, w.x << 16), __builtin_bit_cast(float, w.x & 0xffff0000u), __builtin_bit_cast(float, w.y << 16), __builtin_bit_cast(float, w.y & 0xffff0000u)};
                    f32x4 c = (f32x4){__builtin_bit_cast(float, w.z << 16), __builtin_bit_cast(float, w.z & 0xffff0000u), __builtin_bit_cast(float, w.w << 16), __builtin_bit_cast(float, w.w & 0xffff0000u)};
                    a = a + acc[ai][bj][m][0] * scale; c = c + acc[ai][bj][m][1] * scale;
                    *(u32x4*)(XB + off + bj * HALF) = pack8(a, c);
                    if (W8) { u32x2e w8; w8.x = pk4f8(a[0], a[1], a[2], a[3]); w8.y = pk4f8(c[0], c[1], c[2], c[3]); *(u32x2e*)((unsigned char*)XB + XB8_DELTA + off + bj * HALF) = w8; }
                    ss += ((a[0] * a[0] + a[1] * a[1]) + (a[2] * a[2] + a[3] * a[3])) + ((c[0] * c[0] + c[1] * c[1]) + (c[2] * c[2] + c[3] * c[3])); }
                ss += xor_lane<16>(ss); ss += __builtin_bit_cast(float, __builtin_amdgcn_ds_bpermute((t_ ^ 32) << 2, __builtin_bit_cast(int, ss)));
                if (fq == 0) ssp[(size_t)row * 32 + u.pn * 4 + wc] = ss; }
            asm volatile("" ::: "memory"); }
    }
};
constexpr size_t RSC_DELTA = WS_RSC - WS_XB;
template <bool W8> struct EpiResI8 {
    static constexpr bool PERM = true, AFTER_DRAIN = false;
    bf16_t* XB; float* ssp; const float* csc;
    __device__ __forceinline__ void operator()(const f32x4 (&acc)[2][2][4][2], const Unit& u, int wr, int wc, int, int) const {
        const int t_ = lane_id(), fr = t_ & 15, fq = t_ >> 4;
        const int row0 = u.pm * BM + wr * 64 + fr, col0 = u.pn * BM + wc * 32 + 8 * fq;
        const float* rsc = (const float*)((const unsigned char*)XB + RSC_DELTA);
        f32x4 cs[2][2];
#pragma unroll
        for (int bj = 0; bj < 2; ++bj) { cs[bj][0] = *(const f32x4*)(csc + col0 + bj * HALF); cs[bj][1] = *(const f32x4*)(csc + col0 + bj * HALF + 4); }
#pragma unroll
        for (int ai = 0; ai < 2; ++ai) {
            u32x4 xw[4][2]; float rsq[4];
#pragma unroll
            for (int m = 0; m < 4; ++m) { rsq[m] = rsc[row0 + ai * HALF + m * 16];
#pragma unroll
                for (int bj = 0; bj < 2; ++bj) xw[m][bj] = *(const u32x4*)(XB + (size_t)(row0 + ai * HALF + m * 16) * 2048 + col0 + bj * HALF); }
            asm volatile("" ::: "memory");
#pragma unroll
            for (int m = 0; m < 4; ++m) { const int row = row0 + ai * HALF + m * 16; const size_t off = (size_t)row * 2048 + col0; float ss = 0.f; const float rsv = rsq[m];
#pragma unroll
                for (int bj = 0; bj < 2; ++bj) { const u32x4 w = xw[m][bj];
                    f32x4 a = (f32x4){__builtin_bit_cast(float, w.x << 16), __builtin_bit_cast(float, w.x & 0xffff0000u), __builtin_bit_cast(float, w.y << 16), __builtin_bit_cast(float, w.y & 0xffff0000u)};
                    f32x4 c = (f32x4){__builtin_bit_cast(float, w.z << 16), __builtin_bit_cast(float, w.z & 0xffff0000u), __builtin_bit_cast(float, w.w << 16), __builtin_bit_cast(float, w.w & 0xffff0000u)};
                    const v4i_t i0 = __builtin_bit_cast(v4i_t, acc[ai][bj][m][0]), i1 = __builtin_bit_cast(v4i_t, acc[ai][bj][m][1]);
#pragma unroll
                    for (int i = 0; i < 4; ++i) { a[i] += (float)i0[i] * (rsv * cs[bj][0][i]); c[i] += (float)i1[i] * (rsv * cs[bj][1][i]); }
                    *(u32x4*)(XB + off + bj * HALF) = pack8(a, c);
                    if (W8) { u32x2e w8; w8.x = pk4f8(a[0], a[1], a[2], a[3]); w8.y = pk4f8(c[0], c[1], c[2], c[3]); *(u32x2e*)((unsigned char*)XB + XB8_DELTA + off + bj * HALF) = w8; }
                    ss += ((a[0] * a[0] + a[1] * a[1]) + (a[2] * a[2] + a[3] * a[3])) + ((c[0] * c[0] + c[1] * c[1]) + (c[2] * c[2] + c[3] * c[3])); }
                ss += xor_lane<16>(ss); ss += __builtin_bit_cast(float, __builtin_amdgcn_ds_bpermute((t_ ^ 32) << 2, __builtin_bit_cast(int, ss)));
                if (fq == 0) ssp[(size_t)row * 32 + u.pn * 4 + wc] = ss; }
            asm volatile("" ::: "memory"); }
    }
};
template <int MODE> struct EpiOut {
    static constexpr bool PERM = true, AFTER_DRAIN = false;
    const PG8_LAS float* rtab; bf16_t* O; float scale; size_t tstride;
    __device__ __forceinline__ void operator()(const f32x4 (&acc)[2][2][4][2], const Unit& u, int wr, int wc, int, int) const {
        const int t_ = lane_id(), fr = t_ & 15, fq = t_ >> 4;
        const int row0 = u.pm * BM + wr * 64 + fr, p0 = wc * 32 + 8 * fq;
        float rs[2][4];
        if (MODE != 2) rstd8(rtab, u, wr, fr, rs);
#pragma unroll
        for (int ai = 0; ai < 2; ++ai)
#pragma unroll
            for (int m = 0; m < 4; ++m) { const int row = row0 + ai * HALF + m * 16;
#pragma unroll
                for (int bj = 0; bj < 2; ++bj) { f32x4 a = acc[ai][bj][m][0], c = acc[ai][bj][m][1]; bf16_t* dst;
                    if (MODE == 0) { const float r = rs[ai][m] * scale; a = a * r; c = c * r; dst = O + (((size_t)((row >> 12) * 4 + u.pn * 2 + bj) * 4096 + (row & 4095)) * 128 + p0); }
                    else if (MODE == 1) { const float r = rs[ai][m]; a = a * r; c = c * r;
#pragma unroll
                        for (int i = 0; i < 4; ++i) { a[i] = fmaxf(a[i], 0.f); a[i] *= a[i]; c[i] = fmaxf(c[i], 0.f); c[i] *= c[i]; }
                        dst = O + (size_t)row * 8192 + u.pn * BM + bj * HALF + p0; }
                    else if (MODE == 3) { const float r = rs[ai][m] * scale; a = a * r; c = c * r;
#pragma unroll
                        for (int i = 0; i < 4; ++i) { a[i] = fmaxf(a[i], 0.f); a[i] *= a[i]; c[i] = fmaxf(c[i], 0.f); c[i] *= c[i]; }
                        u32x2e w8; w8.x = pk4f8(a[0], a[1], a[2], a[3]); w8.y = pk4f8(c[0], c[1], c[2], c[3]);
                        *(u32x2e*)((unsigned char*)O + (size_t)row * 8192 + u.pn * BM + bj * HALF + p0) = w8; continue; }
                    else { const int l = u.pn >> 2, t = (u.pn >> 1) & 1, h = (u.pn & 1) * 2 + bj; dst = O + (size_t)t * tstride + ((((size_t)(l * 4 + u.pm) * 4 + h) * 256 + (row & 255)) * 128 + p0); }
                    *(u32x4*)dst = pack8(a, c); }
                if (m & 1) asm volatile("" ::: "memory"); }
    }
};
}

struct Args { const float* in[17]; float* out; unsigned char* ws; int ph_lo, ph_hi; };
struct Frame {
    LAS unsigned char* lds;
    int lane, wave, gw, ngw;
    float* X; unsigned char* ws;
};

template <class RowMap, class Gain>
__device__ __forceinline__ void transpose_item(const float* W, int K, int N, bf16* WT, const RowMap& rm, const Gain& gn, LAS float* scr, int item, int lane) {
    const int nblk = N / 32, kb = item / nblk, nb = item % nblk, k0 = 64 * kb, n0 = 32 * nb;
#pragma unroll 8
    for (int i = 0; i < 32; ++i) { const int kk = 2 * i + (lane >> 5); scr[kk * 33 + (lane & 31)] = __builtin_nontemporal_load(&W[(size_t)(k0 + kk) * N + n0 + (lane & 31)]) * gn(k0 + kk); }
    LDS_WAIT(); asm volatile("" ::: "memory");
    const int c = lane & 7;
#pragma unroll
    for (int j = 0; j < 4; ++j) { const int n = (lane >> 3) + 8 * j; const LAS float* s = scr + (8 * c) * 33 + n;
        u32x4 o; o.x = pk2(s[0 * 33], s[1 * 33]); o.y = pk2(s[2 * 33], s[3 * 33]); o.z = pk2(s[4 * 33], s[5 * 33]); o.w = pk2(s[6 * 33], s[7 * 33]);
        *(u32x4*)(WT + (size_t)rm(n0 + n) * K + k0 + 8 * c) = o; }
    LDS_WAIT(); asm volatile("" ::: "memory");
}
template <class Gain>
__device__ __forceinline__ void transpose_item8(const float* W, int K, int N, unsigned char* WT, const Gain& gn, LAS float* scr, int item, int lane) {
    const int nblk = N / 32, kb = item / nblk, nb = item % nblk, k0 = 64 * kb, n0 = 32 * nb;
#pragma unroll 8
    for (int i = 0; i < 32; ++i) { const int kk = 2 * i + (lane >> 5); scr[kk * 33 + (lane & 31)] = __builtin_nontemporal_load(&W[(size_t)(k0 + kk) * N + n0 + (lane & 31)]) * gn(k0 + kk); }
    LDS_WAIT(); asm volatile("" ::: "memory");
    const int c = lane & 7;
#pragma unroll
    for (int j = 0; j < 4; ++j) { const int n = (lane >> 3) + 8 * j; const LAS float* s = scr + (8 * c) * 33 + n;
        u32x2 o; o.x = pk4f8(s[0 * 33], s[1 * 33], s[2 * 33], s[3 * 33]); o.y = pk4f8(s[4 * 33], s[5 * 33], s[6 * 33], s[7 * 33]);
        *(u32x2*)(WT + (size_t)(n0 + n) * K + k0 + 8 * c) = o; }
    LDS_WAIT(); asm volatile("" ::: "memory");
}
struct GnVecS { const float* g; float s; __device__ __forceinline__ float operator()(int k) const { return g[k] * s; } };
struct GnConst { float s; __device__ __forceinline__ float operator()(int) const { return s; } };
struct RmId { int off; __device__ __forceinline__ int operator()(int n) const { return off + n; } };
struct RmQkv { __device__ __forceinline__ int operator()(int n) const {
    const int t = n >> 11, head = (n >> 7) & 15, d = n & 127; const bool rope = t < 2 && (head < 4 || head >= 10);
    const int p = rope ? (8 * ((d & 63) >> 2) + 4 * (d >> 6) + (d & 3)) : d; return (n & ~127) + p; } };
struct GnOne { __device__ __forceinline__ float operator()(int) const { return 1.f; } };
struct GnVec { const float* g; __device__ __forceinline__ float operator()(int k) const { return g[k]; } };
struct GnOut { const float *ga, *gb, *gc; __device__ __forceinline__ float operator()(int k) const { return k < 512 ? ga[k] : (k < 1280 ? gb[k - 512] : gc[k - 1280]); } };

__device__ __forceinline__ void phase_pro0(Frame& F, const Args& A) {
    LAS float* scr = (LAS float*)(F.lds + F.wave * 16384);
    const float *g_mix = A.in[2], *w_in = A.in[3], *g_oa = A.in[4], *g_ob = A.in[5], *g_oc = A.in[6], *w_out = A.in[7], *g_cross = A.in[8], *g_mem = A.in[9];
    const float *w_cq = A.in[10], *w_ckv = A.in[11], *w_co = A.in[12], *g_mlp = A.in[13], *w_up = A.in[14], *w_down = A.in[15];
    constexpr int I_IN = (DM / 64) * (NQKV / 32), I_OUT = OUT_I8 ? 0 : (OW / 64) * (DM / 32), I_CQ = (DM / 64) * (CW / 32), I_CO = (CW / 64) * (DM / 32), I_UP = (DM / 64) * (FF / 32), I_DN = (FF / 64) * (DM / 32), I_CKV = (DM / 64) * (2 * CW / 32);
    constexpr int I_LAYER = I_IN + I_OUT + I_CQ + I_CO + I_UP + I_DN + I_CKV;
#if OUT_I8
    for (int strip = F.gw >> 3; strip < DEPTH * (DM / 32); strip += F.ngw >> 3) { const int l = strip / (DM / 32), n0 = 32 * (strip % (DM / 32));
        const float* W = w_out + (size_t)l * OW * DM; const GnOut gn{g_oa + l * 512, g_ob + l * 768, g_oc + l * 256};
        float mx = 0.f;
#pragma unroll 1
        for (int t = 0; t < 3; ++t) { const int k0 = 64 * (F.wave * 3 + t);
#pragma unroll 8
            for (int i = 0; i < 32; ++i) { const int kk = 2 * i + (F.lane >> 5); mx = fmaxf(mx, fabsf(W[(size_t)(k0 + kk) * DM + n0 + (F.lane & 31)] * gn(k0 + kk))); } }
        mx = fmaxf(mx, __builtin_bit_cast(float, __builtin_amdgcn_ds_bpermute((F.lane ^ 32) << 2, __builtin_bit_cast(int, mx))));
        LAS float* cmx = (LAS float*)(F.lds + 12288);
        if (F.lane < 32) cmx[F.wave * 32 + F.lane] = mx;
        __syncthreads();
        float cm = 0.f;
#pragma unroll
        for (int w = 0; w < 8; ++w) cm = fmaxf(cm, cmx[w * 32 + (F.lane & 31)]);
        const float inv = cm > 0.f ? 127.f / cm : 0.f;
        if (F.wave == 0 && F.lane < 32) ((float*)(F.ws + WS_CSC))[l * DM + n0 + F.lane] = cm * (1.f / 127.f);
        unsigned char* WT = F.ws + WS_WOUT + (size_t)l * DM * OW;
#pragma unroll 1
        for (int t = 0; t < 3; ++t) { const int k0 = 64 * (F.wave * 3 + t);
#pragma unroll 8
            for (int i = 0; i < 32; ++i) { const int kk = 2 * i + (F.lane >> 5); scr[kk * 33 + (F.lane & 31)] = rintf(W[(size_t)(k0 + kk) * DM + n0 + (F.lane & 31)] * gn(k0 + kk) * inv); }
            LDS_WAIT(); asm volatile("" ::: "memory");
            const int c = F.lane & 7;
#pragma unroll
            for (int j = 0; j < 4; ++j) { const int n = (F.lane >> 3) + 8 * j; const LAS float* sp = scr + (8 * c) * 33 + n; int q[8];
#pragma unroll
                for (int e = 0; e < 8; ++e) q[e] = (int)sp[e * 33] & 255;
                u32x2 o; o.x = (unsigned)(q[0] | (q[1] << 8) | (q[2] << 16) | (q[3] << 24)); o.y = (unsigned)(q[4] | (q[5] << 8) | (q[6] << 16) | (q[7] << 24));
                *(u32x2*)(WT + (size_t)(n0 + n) * OW + k0 + 8 * c) = o; }
            LDS_WAIT(); asm volatile("" ::: "memory"); }
        __syncthreads();
    }
#endif
    for (int it = F.gw; it < I_LAYER * DEPTH; it += F.ngw) {
        const int l = it / I_LAYER; int r = it % I_LAYER;
        if (r < I_IN) {
            if (V_FP8 && (r % (NQKV / 32)) >= 2 * DM / 32) transpose_item8(w_in + (size_t)l * DM * NQKV, DM, NQKV, F.ws + WS_WV8 + (size_t)l * DM * DM - (size_t)2 * DM * DM, GnVecS{g_mix + l * DM, W8_V_SCALE}, scr, r, F.lane);
            else transpose_item(w_in + (size_t)l * DM * NQKV, DM, NQKV, (bf16*)(F.ws + WS_WIN) + (size_t)l * NQKV * DM, RmQkv{}, GnVec{g_mix + l * DM}, scr, r, F.lane);
            continue; } r -= I_IN;
        if (r < I_OUT) { transpose_item(w_out + (size_t)l * OW * DM, OW, DM, (bf16*)(F.ws + WS_WOUT) + (size_t)l * DM * OW, RmId{0}, GnOut{g_oa + l * 512, g_ob + l * 768, g_oc + l * 256}, scr, r, F.lane); continue; } r -= I_OUT;
        if (r < I_CQ) {
            if (CQ_FP8) transpose_item8(w_cq + (size_t)l * DM * CW, DM, CW, F.ws + WS_WCQ + (size_t)l * CW * DM, GnVecS{g_cross + l * DM, W8_CQ_SCALE}, scr, r, F.lane);
            else transpose_item(w_cq + (size_t)l * DM * CW, DM, CW, (bf16*)(F.ws + WS_WCQ) + (size_t)l * CW * DM, RmId{0}, GnVec{g_cross + l * DM}, scr, r, F.lane);
            continue; } r -= I_CQ;
        if (r < I_CO) {
            if (CO_FP8) transpose_item8(w_co + (size_t)l * CW * DM, CW, DM, F.ws + WS_WCO + (size_t)l * DM * CW, GnConst{W8_CO_SCALE}, scr, r, F.lane);
            else transpose_item(w_co + (size_t)l * CW * DM, CW, DM, (bf16*)(F.ws + WS_WCO) + (size_t)l * DM * CW, RmId{0}, GnOne{}, scr, r, F.lane);
            continue; } r -= I_CO;
        #if MLP_FP8
        if (r < I_UP) { transpose_item8(w_up + (size_t)l * DM * FF, DM, FF, F.ws + WS_WUP + (size_t)l * FF * DM, GnVecS{g_mlp + l * DM, W8_UP_SCALE}, scr, r, F.lane); continue; } r -= I_UP;
        if (r < I_DN) { transpose_item8(w_down + (size_t)l * FF * DM, FF, DM, F.ws + WS_WDN + (size_t)l * DM * FF, GnConst{W8_DN_SCALE}, scr, r, F.lane); continue; } r -= I_DN;
#else
        if (r < I_UP) { transpose_item(w_up + (size_t)l * DM * FF, DM, FF, (bf16*)(F.ws + WS_WUP) + (size_t)l * FF * DM, RmId{0}, GnVec{g_mlp + l * DM}, scr, r, F.lane); continue; } r -= I_UP;
        if (r < I_DN) { transpose_item(w_down + (size_t)l * FF * DM, FF, DM, (bf16*)(F.ws + WS_WDN) + (size_t)l * DM * FF, RmId{0}, GnOne{}, scr, r, F.lane); continue; } r -= I_DN;
#endif
        transpose_item(w_ckv + (size_t)l * DM * 2 * CW, DM, 2 * CW, (bf16*)(F.ws + WS_WCKV), RmId{l * 2 * CW}, GnOne{}, scr, r, F.lane);
    }
    { float* cosT = (float*)(F.ws + WS_ROPE); float* sinT = cosT + SEQ * 64;
      for (int i = F.gw * 64 + F.lane; i < SEQ * 64; i += F.ngw * 64) { const int pos = i >> 6, f = i & 63;
          const float inv = 1.0f / powf(10000.0f, (float)(2 * f) / 128.0f); const float ang = (float)pos * inv; cosT[i] = cosf(ang); sinT[i] = sinf(ang); } }
    { const float* mem = A.in[1]; bf16* MN = (bf16*)(F.ws + WS_MEMN);
      for (int row = F.gw; row < MROWS; row += F.ngw) { const f32x4* xr = (const f32x4*)(mem + (size_t)row * DM) + F.lane; f32x4 v[8]; float s = 0.f;
#pragma unroll
          for (int j = 0; j < 8; ++j) { v[j] = xr[64 * j]; s += (v[j].x * v[j].x + v[j].y * v[j].y) + (v[j].z * v[j].z + v[j].w * v[j].w); }
          const float rs = 1.0f / sqrtf(wave_sum(s) * (1.f / DM) + EPS);
#pragma unroll
          for (int j = 0; j < 8; ++j) { const f32x4 g = ((const f32x4*)g_mem)[64 * j + F.lane]; u32x2 o; o.x = pk2(v[j].x * rs * g.x, v[j].y * rs * g.y); o.y = pk2(v[j].z * rs * g.z, v[j].w * rs * g.w);
              *(u32x2*)(MN + (size_t)row * DM + 4 * (64 * j + F.lane)) = o; } } }
    { const float* x = A.in[0]; bf16* XB = (bf16*)(F.ws + WS_XB); float* ssp = (float*)(F.ws + WS_SSP);
      for (int row = F.gw; row < M; row += F.ngw) { const f32x4* xr = (const f32x4*)(x + (size_t)row * DM) + F.lane; float s = 0.f;
#pragma unroll
          for (int j = 0; j < 8; ++j) { const f32x4 v = __builtin_nontemporal_load(&xr[64 * j]); s += (v.x * v.x + v.y * v.y) + (v.z * v.z + v.w * v.w); u32x2 o; o.x = pk2(v.x, v.y); o.y = pk2(v.z, v.w);
              *(u32x2*)(XB + (size_t)row * DM + 4 * (64 * j + F.lane)) = o;
              if (V_FP8) *(unsigned*)(F.ws + WS_XB8 + (size_t)row * DM + 4 * (64 * j + F.lane)) = pk4f8(v.x, v.y, v.z, v.w); }
          s = wave_sum(s); if (F.lane < 32) ssp[(size_t)row * 32 + F.lane] = F.lane == 0 ? s : 0.f; } }
}

template <class Epi>
__device__ __forceinline__ void ngemm(Frame& F, const bf16* A, const bf16* Bt, int Mr, int N, int K, const Epi& epi) {
    const int fr = F.lane & 15, fq = F.lane >> 4, tilesN = N / 64, tiles = (Mr / 64) * tilesN;
    for (int t = F.gw; t < tiles; t += F.ngw) {
        const int tm = t / tilesN, tn = t % tilesN;
        f32x4 acc[4][4];
#pragma unroll
        for (int i = 0; i < 4; ++i)
#pragma unroll
            for (int j = 0; j < 4; ++j) acc[i][j] = (f32x4){0.f, 0.f, 0.f, 0.f};
        const bf16* Ap = A + (size_t)(tm * 64 + fr) * K + fq * 8; const bf16* Bp = Bt + (size_t)(tn * 64 + fr) * K + fq * 8;
        for (int k0 = 0; k0 < K; k0 += 32) {
            bf16x8 a[4], b[4];
#pragma unroll
            for (int i = 0; i < 4; ++i) a[i] = *(const bf16x8*)(Ap + (size_t)i * 16 * K + k0);
#pragma unroll
            for (int j = 0; j < 4; ++j) b[j] = *(const bf16x8*)(Bp + (size_t)j * 16 * K + k0);
#pragma unroll
            for (int i = 0; i < 4; ++i)
#pragma unroll
                for (int j = 0; j < 4; ++j) acc[i][j] = __builtin_amdgcn_mfma_f32_16x16x32_bf16(b[j], a[i], acc[i][j], 0, 0, 0);
        }
        epi.tile(tm * 64, tn * 64, acc, fr, fq);
    }
}
__device__ __forceinline__ void st4bf(bf16* p, f32x4 v) { u32x2 o; o.x = pk2(v.x, v.y); o.y = pk2(v.z, v.w); *(u32x2*)p = o; }

struct NEpiQKV { const float* ssp; const float* cosT; const float* sinT; bf16 *Q;
    __device__ __forceinline__ void tile(int rb, int cb, f32x4 (&acc)[4][4], int fr, int fq) const {
#pragma unroll
        for (int i = 0; i < 4; ++i) { const int row = rb + 16 * i + fr, b = row >> 12, s = row & 4095; const float rs = rstd_from_ssp(ssp, row, 1.f / DM);
#pragma unroll
            for (int j = 0; j < 4; ++j) { const int n0 = cb + 16 * j + 4 * fq, t = n0 >> 11, head = (n0 >> 7) & 15, p0 = n0 & 127;
                f32x4 v = acc[i][j] * rs, pv;
#pragma unroll
                for (int r = 0; r < 4; ++r) pv[r] = __shfl_xor(v[r], 16);
                if (t < 2 && (head < 4 || head >= 10)) { const int hb = fq & 1, f0 = 4 * (p0 >> 3);
                    const f32x4 c = *(const f32x4*)(cosT + s * 64 + f0), sn = *(const f32x4*)(sinT + s * 64 + f0);
                    v = hb == 0 ? v * c - pv * sn : v * c + pv * sn; }
                if (t == 0) v = v * C2;
                bf16* dst = Q + (size_t)t * ((WS_K - WS_Q) / 2) + (((size_t)(b * 16 + head) * SEQ + s) * HD + p0);
                st4bf(dst, v); } }
    } };
struct NEpiRes { const float* base; float* X; bf16* XB; float* ssp;
    __device__ __forceinline__ void tile(int rb, int cb, f32x4 (&acc)[4][4], int fr, int fq) const {
#pragma unroll
        for (int i = 0; i < 4; ++i) { const int row = rb + 16 * i + fr; float ss = 0.f;
#pragma unroll
            for (int j = 0; j < 4; ++j) { const size_t off = (size_t)row * DM + cb + 16 * j + 4 * fq; const f32x4 xn = *(const f32x4*)(base + off) + acc[i][j];
                *(f32x4*)(X + off) = xn; st4bf(XB + off, xn); ss += (xn.x * xn.x + xn.y * xn.y) + (xn.z * xn.z + xn.w * xn.w); }
            ss += __shfl_xor(ss, 16); ss += __shfl_xor(ss, 32); if (fq == 0) ssp[(size_t)row * 32 + (cb >> 6)] = ss; }
    } };
struct NEpiCq { const float* ssp; bf16* QC;
    __device__ __forceinline__ void tile(int rb, int cb, f32x4 (&acc)[4][4], int fr, int fq) const {
#pragma unroll
        for (int i = 0; i < 4; ++i) { const int row = rb + 16 * i + fr, b = row >> 12, s = row & 4095; const float rs = rstd_from_ssp(ssp, row, 1.f / DM) * C2;
#pragma unroll
            for (int j = 0; j < 4; ++j) { const int n0 = cb + 16 * j + 4 * fq, h = n0 >> 7, d = n0 & 127; st4bf(QC + (((size_t)(b * 4 + h) * SEQ + s) * HD + d), acc[i][j] * rs); } }
    } };
struct NEpiUp { const float* ssp; bf16* ACT;
    __device__ __forceinline__ void tile(int rb, int cb, f32x4 (&acc)[4][4], int fr, int fq) const {
#pragma unroll
        for (int i = 0; i < 4; ++i) { const int row = rb + 16 * i + fr; const float rs = rstd_from_ssp(ssp, row, 1.f / DM);
#pragma unroll
            for (int j = 0; j < 4; ++j) { f32x4 v = acc[i][j] * rs; v.x = fmaxf(v.x, 0.f); v.y = fmaxf(v.y, 0.f); v.z = fmaxf(v.z, 0.f); v.w = fmaxf(v.w, 0.f);
                st4bf(ACT + (size_t)row * FF + cb + 16 * j + 4 * fq, v * v); } }
    } };
struct NEpiCkv { bf16 *CK;
    __device__ __forceinline__ void tile(int rb, int cb, f32x4 (&acc)[4][4], int fr, int fq) const {
#pragma unroll
        for (int i = 0; i < 4; ++i) { const int row = rb + 16 * i + fr, b = row >> 8, m = row & 255;
#pragma unroll
            for (int j = 0; j < 4; ++j) { const int n0 = cb + 16 * j + 4 * fq, l = n0 >> 10, t = (n0 >> 9) & 1, h = (n0 >> 7) & 3, d = n0 & 127;
                st4bf(CK + (size_t)t * ((WS_CV - WS_CK) / 2) + ((((size_t)(l * 4 + b) * 4 + h) * MEML + m) * HD + d), acc[i][j]); } }
    } };

__device__ __forceinline__ void load_q(const bf16* qrow, LAS float* qs, int lane) { const unsigned w = ((const unsigned*)qrow)[lane]; qs[2 * lane] = bflo(w); qs[2 * lane + 1] = bfhi(w); LDS_WAIT(); asm volatile("" ::: "memory"); }
__device__ __forceinline__ float dot_qk(const bf16* krow, const LAS float* qs) {
    float s = 0.f;
#pragma unroll
    for (int c = 0; c < 16; ++c) { const u32x4 w = ((const u32x4*)krow)[c]; const f32x4 q0 = ((const LAS f32x4*)qs)[2 * c], q1 = ((const LAS f32x4*)qs)[2 * c + 1];
        s += bflo(w.x) * q0.x + bfhi(w.x) * q0.y + bflo(w.y) * q0.z + bfhi(w.y) * q0.w + bflo(w.z) * q1.x + bfhi(w.z) * q1.y + bflo(w.w) * q1.z + bfhi(w.w) * q1.w; }
    return s;
}
__device__ __forceinline__ void pv_acc(const bf16* Vh, int k0, int kstep, int cnt, float p, float& o0, float& o1, int lane) {
    for (int s = 0; s < cnt; ++s) { const float ps = __builtin_bit_cast(float, __builtin_amdgcn_readlane(__builtin_bit_cast(int, p), s));
        const unsigned vv = ((const unsigned*)(Vh + (size_t)(k0 + s * kstep) * HD))[lane]; o0 += ps * bflo(vv); o1 += ps * bfhi(vv); }
}
__device__ __forceinline__ void soft_block(const bf16* Kh, const bf16* Vh, int k0, int kstep, int cnt, const LAS float* qs, float& m, float& l, float& o0, float& o1, int lane) {
    float sc = -__builtin_inff(); if (lane < cnt) sc = dot_qk(Kh + (size_t)(k0 + lane * kstep) * HD, qs);
    const float mn = fmaxf(m, wave_max(sc)), alpha = ex2(m - mn), p = lane < cnt ? ex2(sc - mn) : 0.f;
    l = l * alpha + wave_sum(p); o0 *= alpha; o1 *= alpha; m = mn;
    pv_acc(Vh, k0, kstep, cnt, p, o0, o1, lane);
}
__device__ __forceinline__ void naive_kmean(Frame& F) {
    const bf16* K = (const bf16*)(F.ws + WS_K); float* KMP = (float*)(F.ws + WS_KMP);
    for (int it = F.gw; it < BATCH * 4 * 16 * 2; it += F.ngw) { const int half = it & 1, blk = (it >> 1) & 15, bh = it >> 5, b = bh >> 2, h = bh & 3;
        const bf16* kp = K + ((size_t)(b * 16 + h) * SEQ + blk * 256 + half * 128) * HD; float s0 = 0.f, s1 = 0.f;
        for (int r = 0; r < 128; ++r) { const unsigned w = ((const unsigned*)(kp + (size_t)r * HD))[F.lane]; s0 += bflo(w); s1 += bfhi(w); }
        KMP[(size_t)it * HD + 2 * F.lane] = s0; KMP[(size_t)it * HD + 2 * F.lane + 1] = s1; }
}
__device__ __forceinline__ void naive_attention(Frame& F) {
    LAS float* qs = (LAS float*)(F.lds + F.wave * 512);
    const bf16 *Q = (const bf16*)(F.ws + WS_Q), *K = (const bf16*)(F.ws + WS_K), *V = (const bf16*)(F.ws + WS_V);
    bf16 *OA = (bf16*)(F.ws + WS_OA), *OB = (bf16*)(F.ws + WS_OB), *OC = (bf16*)(F.ws + WS_OC); float* LSE = (float*)(F.ws + WS_LSE); const float* KMP = (const float*)(F.ws + WS_KMP);
    const int lane = F.lane;
    for (int it = F.gw; it < BATCH * 4 * SEQ; it += F.ngw) { const int s = it & 4095, bh = it >> 12, b = bh >> 2, h = bh & 3, own = s >> 8;
        const size_t hb = (size_t)(b * 16 + h) * SEQ; const bf16 *Kh = K + hb * HD, *Vh = V + hb * HD;
        load_q(Q + (hb + s) * HD, qs, lane);
        float g[16];
#pragma unroll
        for (int j = 0; j < 16; ++j) { const float* km = KMP + ((size_t)(bh * 16 + j) * 2) * HD;
            const float k0 = (km[2 * lane] + km[HD + 2 * lane]) * (1.f / 256.f), k1 = (km[2 * lane + 1] + km[HD + 2 * lane + 1]) * (1.f / 256.f);
            const float d = wave_sum(qs[2 * lane] * k0 + qs[2 * lane + 1] * k1); g[j] = j < own ? d : -__builtin_inff(); }
        int sel[3];
#pragma unroll
        for (int r = 0; r < 3; ++r) { float best = -__builtin_inff(); int bi = -1;
#pragma unroll
            for (int j = 0; j < 16; ++j) if (g[j] > best) { best = g[j]; bi = j; }
#pragma unroll
            for (int j = 0; j < 16; ++j) if (j == bi) g[j] = -__builtin_inff();
            sel[r] = bi; }
        float m = -1e30f, l = 0.f, o0 = 0.f, o1 = 0.f;
#pragma unroll
        for (int r = 0; r < 3; ++r) if (sel[r] >= 0) for (int c = 0; c < 4; ++c) soft_block(Kh, Vh, sel[r] * 256 + 64 * c, 1, 64, qs, m, l, o0, o1, lane);
        const int n = s - own * 256 + 1;
        for (int c = 0; 64 * c < n; ++c) soft_block(Kh, Vh, own * 256 + 64 * c, 1, (n - 64 * c) < 64 ? (n - 64 * c) : 64, qs, m, l, o0, o1, lane);
        const float il = 1.f / l; ((unsigned*)(OA + (size_t)(b * SEQ + s) * 512 + h * HD))[lane] = pk2(o0 * il, o1 * il); }
    for (int it = F.gw; it < BATCH * 6 * SEQ; it += F.ngw) { const int s = it & 4095, bh = it >> 12, b = bh / 6, h = 4 + bh % 6;
        const size_t hb = (size_t)(b * 16 + h) * SEQ; const bf16 *Kh = K + hb * HD, *Vh = V + hb * HD;
        load_q(Q + (hb + s) * HD, qs, lane);
        float carry = 0.f, o0 = 0.f, o1 = 0.f;
        for (int c = 0; 64 * c < s; ++c) { const int cnt = (s - 64 * c) < 64 ? (s - 64 * c) : 64, k0 = s - 1 - 64 * c;
            float y = 0.f, sp = 0.f; if (lane < cnt) { y = dot_qk(Kh + (size_t)(k0 - lane) * HD, qs); sp = fmaxf(y, 0.f) + lg2(1.f + ex2(-fabsf(y))); }
            float inc = sp;
#pragma unroll
            for (int o = 1; o < 64; o <<= 1) { const float t = __shfl_up(inc, o); if (lane >= o) inc += t; }
            const float w = lane < cnt ? ex2(y - (carry + inc)) : 0.f;
            carry += __shfl(inc, 63);
            pv_acc(Vh, k0, -1, cnt, w, o0, o1, lane); }
        ((unsigned*)(OB + (size_t)(b * SEQ + s) * 768 + (h - 4) * HD))[lane] = pk2(o0, o1); }
    for (int it = F.gw; it < BATCH * 6 * SEQ; it += F.ngw) { const int s = it & 4095, bh = it >> 12, b = bh / 6, hc = bh % 6, h = 10 + hc, g = hc >> 1, jj = hc & 1, d = g == 0 ? 1 : (g == 1 ? 4 : 16);
        const size_t hb = (size_t)(b * 16 + h) * SEQ; const bf16 *Kh = K + hb * HD, *Vh = V + hb * HD;
        load_q(Q + (hb + s) * HD, qs, lane);
        const int pm = s / d, nk = (pm < 128 ? pm : 128) + 1;
        float m = -1e30f, l = 0.f, o0 = 0.f, o1 = 0.f;
        for (int c = 0; 64 * c < nk; ++c) soft_block(Kh, Vh, s - 64 * c * d, -d, (nk - 64 * c) < 64 ? (nk - 64 * c) : 64, qs, m, l, o0, o1, lane);
        const float il = 1.f / l; const size_t row = (size_t)(b * SEQ + s);
        ((unsigned*)(OC + ((size_t)g * M + row) * 256 + jj * HD))[lane] = pk2(o0 * il, o1 * il);
        if (lane == 0) LSE[((size_t)g * M + row) * 2 + jj] = m + lg2(l); }
}
__device__ __forceinline__ void naive_xattn(Frame& F, int layer) {
    LAS float* qs = (LAS float*)(F.lds + F.wave * 512); const int lane = F.lane;
    const bf16 *QC = (const bf16*)(F.ws + WS_QC), *CK = (const bf16*)(F.ws + WS_CK), *CV = (const bf16*)(F.ws + WS_CV); bf16* OCR = (bf16*)(F.ws + WS_OCR);
    for (int it = F.gw; it < BATCH * 4 * SEQ; it += F.ngw) { const int s = it & 4095, bh = it >> 12, b = bh >> 2, h = bh & 3;
        const size_t kb = ((size_t)(layer * 4 + b) * 4 + h) * MEML * HD; const bf16 *Kh = CK + kb, *Vh = CV + kb;
        load_q(QC + ((size_t)bh * SEQ + s) * HD, qs, lane);
        float m = -1e30f, l = 0.f, o0 = 0.f, o1 = 0.f;
        for (int c = 0; c < 4; ++c) soft_block(Kh, Vh, 64 * c, 1, 64, qs, m, l, o0, o1, lane);
        const float il = 1.f / l; ((unsigned*)(OCR + (size_t)(b * SEQ + s) * CW + h * HD))[lane] = pk2(o0 * il, o1 * il); }
}
__device__ __forceinline__ void phase_merge(Frame& F) {
    const bf16 *OA = (const bf16*)(F.ws + WS_OA), *OB = (const bf16*)(F.ws + WS_OB), *OC = (const bf16*)(F.ws + WS_OC); const float* LSE = (const float*)(F.ws + WS_LSE); bf16* MRG = (bf16*)(F.ws + WS_MRG);
    const int lane = F.lane, jj = lane >> 5;
    for (int row0 = F.gw; row0 < M; row0 += 2 * F.ngw) {
        const bool two = row0 + F.ngw < M;
        u32x4 wa[2]; u32x2 wb[2][3], wc[2][3]; float ls[2][3];
#if MOBA_GATHER
        u32x4 wp[2][3]; float lp[2][4];
#endif
#pragma unroll
        for (int q = 0; q < 2; ++q) { const int row = (q && two) ? row0 + F.ngw : row0;
#if MOBA_GATHER
            wa[q] = ((const u32x4*)((const bf16*)(F.ws + WS_PART) + ((size_t)3 * M + row) * 512))[lane];
#pragma unroll
            for (int sl = 0; sl < 3; ++sl) wp[q][sl] = ((const u32x4*)((const bf16*)(F.ws + WS_PART) + ((size_t)sl * M + row) * 512))[lane];
#pragma unroll
            for (int sl = 0; sl < 4; ++sl) lp[q][sl] = ((const float*)(F.ws + WS_PLSE))[((size_t)sl * M + row) * 4 + (lane >> 4)];
#else
            wa[q] = ((const u32x4*)(OA + (size_t)row * 512))[lane];
#endif
#pragma unroll
            for (int k = 0; k < 3; ++k) { wb[q][k] = ((const u32x2*)(OB + (size_t)row * 768))[lane + 64 * k]; wc[q][k] = ((const u32x2*)(OC + ((size_t)k * M + row) * 256))[lane]; ls[q][k] = LSE[((size_t)k * M + row) * 2 + jj]; } }
#if OUT_I8
#pragma unroll
        for (int q = 0; q < 2; ++q) { const int row = row0 + q * F.ngw; if (q && !two) break;
            float va[8], vb[12], vc[4]; float amax;
            { const u32x4 w = wa[q]; float v[8] = {bflo(w.x), bfhi(w.x), bflo(w.y), bfhi(w.y), bflo(w.z), bfhi(w.z), bflo(w.w), bfhi(w.w)}; float ss = 0.f;
#if MOBA_GATHER
              { const float mxl = fmaxf(fmaxf(lp[q][0], lp[q][1]), fmaxf(lp[q][2], lp[q][3])); float wt[4], wsum = 0.f;
#pragma unroll
                for (int sl = 0; sl < 4; ++sl) { wt[sl] = ex2(lp[q][sl] - mxl); wsum += wt[sl]; }
                const float iw = 1.f / wsum;
#pragma unroll
                for (int i = 0; i < 8; ++i) v[i] *= wt[3] * iw;
#pragma unroll
                for (int sl = 0; sl < 3; ++sl) { const u32x4 x = wp[q][sl]; const float a = wt[sl] * iw; const float pv[8] = {bflo(x.x), bfhi(x.x), bflo(x.y), bfhi(x.y), bflo(x.z), bfhi(x.z), bflo(x.w), bfhi(x.w)};
#pragma unroll
                    for (int i = 0; i < 8; ++i) v[i] += a > 0.f ? a * pv[i] : 0.f; } }
#endif
#pragma unroll
              for (int i = 0; i < 8; ++i) ss += v[i] * v[i];
              const float rs = 1.0f / sqrtf(wave_sum(ss) * (1.f / 512.f) + EPS); amax = 0.f;
#pragma unroll
              for (int i = 0; i < 8; ++i) { va[i] = v[i] * rs; amax = fmaxf(amax, fabsf(va[i])); } }
            { float ss = 0.f;
#pragma unroll
              for (int k = 0; k < 3; ++k) { const u32x2 w = wb[q][k]; vb[4 * k] = bflo(w.x); vb[4 * k + 1] = bfhi(w.x); vb[4 * k + 2] = bflo(w.y); vb[4 * k + 3] = bfhi(w.y); }
#pragma unroll
              for (int i = 0; i < 12; ++i) ss += vb[i] * vb[i];
              const float rs = 1.0f / sqrtf(wave_sum(ss) * (1.f / 768.f) + EPS);
#pragma unroll
              for (int i = 0; i < 12; ++i) { vb[i] *= rs; amax = fmaxf(amax, fabsf(vb[i])); } }
            { float mx = fmaxf(fmaxf(ls[q][0], ls[q][1]), ls[q][2]); float a[3], as = 0.f;
#pragma unroll
              for (int g = 0; g < 3; ++g) { a[g] = ex2(ls[q][g] - mx); as += a[g]; }
              const float ia = 1.f / as; float v[4] = {0.f, 0.f, 0.f, 0.f};
#pragma unroll
              for (int g = 0; g < 3; ++g) { const u32x2 w = wc[q][g]; const float al = a[g] * ia; v[0] += al * bflo(w.x); v[1] += al * bfhi(w.x); v[2] += al * bflo(w.y); v[3] += al * bfhi(w.y); }
              const float ss = (v[0] * v[0] + v[1] * v[1]) + (v[2] * v[2] + v[3] * v[3]);
              const float rs = 1.0f / sqrtf(wave_sum(ss) * (1.f / 256.f) + EPS);
#pragma unroll
              for (int i = 0; i < 4; ++i) { vc[i] = v[i] * rs; amax = fmaxf(amax, fabsf(vc[i])); } }
            amax = wave_max(amax); const float inv = amax > 0.f ? 127.f / amax : 0.f;
            if (lane == 0) ((float*)(F.ws + WS_RSC))[row] = amax * (1.f / 127.f);
            unsigned char* mr = (unsigned char*)MRG + (size_t)row * OW;
            { u32x2 o; o.x = pk4i8(va[0] * inv, va[1] * inv, va[2] * inv, va[3] * inv); o.y = pk4i8(va[4] * inv, va[5] * inv, va[6] * inv, va[7] * inv); ((u32x2*)mr)[lane] = o; }
#pragma unroll
            for (int k = 0; k < 3; ++k) ((unsigned*)(mr + 512))[lane + 64 * k] = pk4i8(vb[4 * k] * inv, vb[4 * k + 1] * inv, vb[4 * k + 2] * inv, vb[4 * k + 3] * inv);
            ((unsigned*)(mr + 1280))[lane] = pk4i8(vc[0] * inv, vc[1] * inv, vc[2] * inv, vc[3] * inv); }
#else
#pragma unroll
        for (int q = 0; q < 2; ++q) { const int row = row0 + q * F.ngw; if (q && !two) break;
            { const u32x4 w = wa[q]; float v[8] = {bflo(w.x), bfhi(w.x), bflo(w.y), bfhi(w.y), bflo(w.z), bfhi(w.z), bflo(w.w), bfhi(w.w)}; float ss = 0.f;
#pragma unroll
              for (int i = 0; i < 8; ++i) ss += v[i] * v[i];
              const float rs = 1.0f / sqrtf(wave_sum(ss) * (1.f / 512.f) + EPS); u32x4 o; o.x = pk2(v[0] * rs, v[1] * rs); o.y = pk2(v[2] * rs, v[3] * rs); o.z = pk2(v[4] * rs, v[5] * rs); o.w = pk2(v[6] * rs, v[7] * rs);
              ((u32x4*)(MRG + (size_t)row * OW))[lane] = o; }
            { float v[12]; float ss = 0.f;
#pragma unroll
              for (int k = 0; k < 3; ++k) { const u32x2 w = wb[q][k]; v[4 * k] = bflo(w.x); v[4 * k + 1] = bfhi(w.x); v[4 * k + 2] = bflo(w.y); v[4 * k + 3] = bfhi(w.y); }
#pragma unroll
              for (int i = 0; i < 12; ++i) ss += v[i] * v[i];
              const float rs = 1.0f / sqrtf(wave_sum(ss) * (1.f / 768.f) + EPS);
#pragma unroll
              for (int k = 0; k < 3; ++k) { u32x2 o; o.x = pk2(v[4 * k] * rs, v[4 * k + 1] * rs); o.y = pk2(v[4 * k + 2] * rs, v[4 * k + 3] * rs); ((u32x2*)(MRG + (size_t)row * OW + 512))[lane + 64 * k] = o; } }
            { float mx = fmaxf(fmaxf(ls[q][0], ls[q][1]), ls[q][2]); float a[3], as = 0.f;
#pragma unroll
              for (int g = 0; g < 3; ++g) { a[g] = ex2(ls[q][g] - mx); as += a[g]; }
              const float ia = 1.f / as; float v[4] = {0.f, 0.f, 0.f, 0.f};
#pragma unroll
              for (int g = 0; g < 3; ++g) { const u32x2 w = wc[q][g]; const float al = a[g] * ia; v[0] += al * bflo(w.x); v[1] += al * bfhi(w.x); v[2] += al * bflo(w.y); v[3] += al * bfhi(w.y); }
              const float ss = (v[0] * v[0] + v[1] * v[1]) + (v[2] * v[2] + v[3] * v[3]);
              const float rs = 1.0f / sqrtf(wave_sum(ss) * (1.f / 256.f) + EPS); u32x2 o; o.x = pk2(v[0] * rs, v[1] * rs); o.y = pk2(v[2] * rs, v[3] * rs);
              ((u32x2*)(MRG + (size_t)row * OW + 1280))[lane] = o; } }
#endif
    }
}
__device__ __forceinline__ void phase_final(Frame& F, const float* gf) {
    const float* ssp = (const float*)(F.ws + WS_SSP); const bf16* XB = (const bf16*)(F.ws + WS_XB);
    for (int row0 = F.gw; row0 < M; row0 += 2 * F.ngw) {
        const bool two = row0 + F.ngw < M; u32x4 w[2][4]; float ssq[2];
#pragma unroll
        for (int q = 0; q < 2; ++q) { const int row = (q && two) ? row0 + F.ngw : row0; const u32x4* xr = (const u32x4*)(XB + (size_t)row * DM) + F.lane;
#pragma unroll
            for (int j = 0; j < 4; ++j) w[q][j] = xr[64 * j];
            ssq[q] = ssp[(size_t)row * 32 + (F.lane & 31)]; }
#pragma unroll
        for (int q = 0; q < 2; ++q) { const int row = row0 + q * F.ngw; if (q && !two) break;
            float s = ssq[q]; s += xor_lane<1>(s); s += xor_lane<2>(s); s += xor_lane<4>(s); s += xor_lane<8>(s); s += xor_lane<16>(s);
            const float rs = 1.0f / sqrtf(s * (1.f / DM) + EPS); f32x4* orow = (f32x4*)(F.X + (size_t)row * DM);
#pragma unroll
            for (int j = 0; j < 4; ++j) { const u32x4 ww = w[q][j]; const int e = 2 * (64 * j + F.lane); const f32x4 g0 = ((const f32x4*)gf)[e], g1 = ((const f32x4*)gf)[e + 1];
                orow[e] = (f32x4){bflo(ww.x) * rs * g0.x, bfhi(ww.x) * rs * g0.y, bflo(ww.y) * rs * g0.z, bfhi(ww.y) * rs * g0.w};
                orow[e + 1] = (f32x4){bflo(ww.z) * rs * g1.x, bfhi(ww.z) * rs * g1.y, bflo(ww.w) * rs * g1.z, bfhi(ww.w) * rs * g1.w}; } }
    }
}

namespace att {
typedef float f32x16 __attribute__((ext_vector_type(16)));
typedef short s16x4 __attribute__((ext_vector_type(4)));
constexpr int SHM = 16384;
constexpr int OFF_V = 0, OFF_K = 2 * SHM, OFF_WS = 4 * SHM, OFF_FLAG = OFF_WS + 8 * 256, OFF_SLOT = 137216  , ATT_LDS = OFF_FLAG + 64;
#define SBAR() __builtin_amdgcn_sched_barrier(0)
__device__ __forceinline__ int kswz(int row, int colB) { return row * 256 + (colB ^ ((row & 7) << 4)); }
__device__ __forceinline__ int v_st(int k, int c) { const int kk = (k & ~0xC) | ((k & 4) << 1) | ((k & 8) >> 1); return ((kk >> 3) * 4 + (c >> 5)) * 512 + ((kk & 7) * 32 + (c & 31)) * 2; }
__device__ __forceinline__ int v_rd_base(int lane) { return ((lane & 3) << 3) | (((lane >> 2) & 3) << 6) | (((lane >> 4) & 1) << 5) | (((lane >> 5) & 1) << 8); }
constexpr int v_rd_off(int d0, int ks, int half) { return d0 * 512 + ks * 4096 + half * 2048; }
__device__ __forceinline__ int crow(int r, int hi) { return (r & 3) + 8 * (r >> 2) + 4 * hi; }
__device__ __forceinline__ unsigned cvtpk(float lo, float hi) { unsigned r; asm volatile("v_cvt_pk_bf16_f32 %0, %1, %2" : "=v"(r) : "v"(lo), "v"(hi)); return r; }
__device__ __forceinline__ float swap_sum(float v) { float w = v; asm volatile("" : "+v"(w)); auto rr = __builtin_amdgcn_permlane32_swap(__float_as_uint(v), __float_as_uint(w), false, false); return __uint_as_float(rr[0]) + __uint_as_float(rr[1]); }
__device__ __forceinline__ float swap_max(float v) { float w = v; asm volatile("" : "+v"(w)); auto rr = __builtin_amdgcn_permlane32_swap(__float_as_uint(v), __float_as_uint(w), false, false); return fmaxf(__uint_as_float(rr[0]), __uint_as_float(rr[1])); }

template <int KB, bool BOTH>
__device__ __forceinline__ void qkt(f32x16& p0, f32x16& p1, const LAS char* K_lds, int r32, int hi, const bf16x8* qr) {
    unsigned ka[4];
#pragma unroll
    for (int dd = 0; dd < 4; ++dd) ka[dd] = (unsigned)(size_t)K_lds + (unsigned)kswz(r32, (dd * 16 + hi * 8) * 2);
#define KRD(dst, dd, off) asm volatile("ds_read_b128 %0, %1 offset:%2" : "=&v"(dst) : "v"(ka[dd]), "i"(KB * SHM + (off)) : "memory")
#define KWAIT(n) do { SBAR(); asm volatile("s_waitcnt lgkmcnt(" #n ")" ::: "memory"); SBAR(); } while (0)
    if (BOTH) {
        bf16x8 A0, A1, A2, A3, B0, B1, B2, B3, C0, C1, C2, C3;
        KRD(A0, 0, 0); KRD(A1, 0, 8192); KRD(A2, 1, 0); KRD(A3, 1, 8192);
        KRD(B0, 2, 0); KRD(B1, 2, 8192); KRD(B2, 3, 0); KRD(B3, 3, 8192);
        KWAIT(4);
        asm("v_mfma_f32_32x32x16_bf16 %0, %1, %2, 0" : "=&v"(p0) : "v"(A0), "v"(qr[0])); asm("v_mfma_f32_32x32x16_bf16 %0, %1, %2, 0" : "=&v"(p1) : "v"(A1), "v"(qr[0]));
        p0 = __builtin_amdgcn_mfma_f32_32x32x16_bf16(A2, qr[1], p0, 0, 0, 0); p1 = __builtin_amdgcn_mfma_f32_32x32x16_bf16(A3, qr[1], p1, 0, 0, 0);
        SBAR(); KRD(C0, 0, 128); KRD(C1, 0, 128 + 8192); KRD(C2, 1, 128); KRD(C3, 1, 128 + 8192);
        KWAIT(4);
        p0 = __builtin_amdgcn_mfma_f32_32x32x16_bf16(B0, qr[2], p0, 0, 0, 0); p1 = __builtin_amdgcn_mfma_f32_32x32x16_bf16(B1, qr[2], p1, 0, 0, 0);
        p0 = __builtin_amdgcn_mfma_f32_32x32x16_bf16(B2, qr[3], p0, 0, 0, 0); p1 = __builtin_amdgcn_mfma_f32_32x32x16_bf16(B3, qr[3], p1, 0, 0, 0);
        SBAR(); KRD(A0, 2, 128); KRD(A1, 2, 128 + 8192); KRD(A2, 3, 128); KRD(A3, 3, 128 + 8192);
        KWAIT(4);
        p0 = __builtin_amdgcn_mfma_f32_32x32x16_bf16(C0, qr[4], p0, 0, 0, 0); p1 = __builtin_amdgcn_mfma_f32_32x32x16_bf16(C1, qr[4], p1, 0, 0, 0);
        p0 = __builtin_amdgcn_mfma_f32_32x32x16_bf16(C2, qr[5], p0, 0, 0, 0); p1 = __builtin_amdgcn_mfma_f32_32x32x16_bf16(C3, qr[5], p1, 0, 0, 0);
        KWAIT(0);
        p0 = __builtin_amdgcn_mfma_f32_32x32x16_bf16(A0, qr[6], p0, 0, 0, 0); p1 = __builtin_amdgcn_mfma_f32_32x32x16_bf16(A1, qr[6], p1, 0, 0, 0);
        p0 = __builtin_amdgcn_mfma_f32_32x32x16_bf16(A2, qr[7], p0, 0, 0, 0); p1 = __builtin_amdgcn_mfma_f32_32x32x16_bf16(A3, qr[7], p1, 0, 0, 0);
    } else {
        bf16x8 A0, A1, A2, A3, B0, B1, B2, B3;
        KRD(A0, 0, 0); KRD(A1, 1, 0); KRD(A2, 2, 0); KRD(A3, 3, 0); KRD(B0, 0, 128); KRD(B1, 1, 128); KRD(B2, 2, 128); KRD(B3, 3, 128);
        KWAIT(4);
        asm("v_mfma_f32_32x32x16_bf16 %0, %1, %2, 0" : "=&v"(p0) : "v"(A0), "v"(qr[0]));
        p0 = __builtin_amdgcn_mfma_f32_32x32x16_bf16(A1, qr[1], p0, 0, 0, 0); p0 = __builtin_amdgcn_mfma_f32_32x32x16_bf16(A2, qr[2], p0, 0, 0, 0); p0 = __builtin_amdgcn_mfma_f32_32x32x16_bf16(A3, qr[3], p0, 0, 0, 0);
        KWAIT(0);
        p0 = __builtin_amdgcn_mfma_f32_32x32x16_bf16(B0, qr[4], p0, 0, 0, 0); p0 = __builtin_amdgcn_mfma_f32_32x32x16_bf16(B1, qr[5], p0, 0, 0, 0);
        p0 = __builtin_amdgcn_mfma_f32_32x32x16_bf16(B2, qr[6], p0, 0, 0, 0); p0 = __builtin_amdgcn_mfma_f32_32x32x16_bf16(B3, qr[7], p0, 0, 0, 0);
        { float z = 0.f; asm volatile("" : "+v"(z));
#pragma unroll
          for (int r = 0; r < 16; ++r) p1[r] = z; }
    }
#undef KRD
#undef KWAIT
}
template <int VB>
__device__ __forceinline__ void pv_tile(f32x16* o, unsigned vb0, bf16x8 pa0, bf16x8 pa1, bf16x8 pa2, bf16x8 pa3) {
#define TRRD(dst, off) asm volatile("ds_read_b64_tr_b16 %0, %1 offset:%2" : "=&v"(dst) : "v"(vb0), "i"(off) : "memory")
#define PV_LD(S, d0) do { constexpr int b_ = OFF_V + VB * SHM + v_rd_off(d0, 0, 0); \
        TRRD(S##l0, b_); TRRD(S##h0, b_ + 2048); TRRD(S##l1, b_ + 4096); TRRD(S##h1, b_ + 6144); TRRD(S##l2, b_ + 8192); TRRD(S##h2, b_ + 10240); TRRD(S##l3, b_ + 12288); TRRD(S##h3, b_ + 14336); } while (0)
#define PV_MM(S, d0) do { \
        o[d0] = __builtin_amdgcn_mfma_f32_32x32x16_bf16(pa0, (bf16x8){S##l0[0], S##l0[1], S##l0[2], S##l0[3], S##h0[0], S##h0[1], S##h0[2], S##h0[3]}, o[d0], 0, 0, 0); \
        o[d0] = __builtin_amdgcn_mfma_f32_32x32x16_bf16(pa1, (bf16x8){S##l1[0], S##l1[1], S##l1[2], S##l1[3], S##h1[0], S##h1[1], S##h1[2], S##h1[3]}, o[d0], 0, 0, 0); \
        o[d0] = __builtin_amdgcn_mfma_f32_32x32x16_bf16(pa2, (bf16x8){S##l2[0], S##l2[1], S##l2[2], S##l2[3], S##h2[0], S##h2[1], S##h2[2], S##h2[3]}, o[d0], 0, 0, 0); \
        o[d0] = __builtin_amdgcn_mfma_f32_32x32x16_bf16(pa3, (bf16x8){S##l3[0], S##l3[1], S##l3[2], S##l3[3], S##h3[0], S##h3[1], S##h3[2], S##h3[3]}, o[d0], 0, 0, 0); } while (0)
    s16x4 Al0, Al1, Al2, Al3, Ah0, Ah1, Ah2, Ah3, Bl0, Bl1, Bl2, Bl3, Bh0, Bh1, Bh2, Bh3;
    PV_LD(A, 0);
    PV_LD(B, 1); asm volatile("s_waitcnt lgkmcnt(8)" ::: "memory"); SBAR(); PV_MM(A, 0); SBAR();
    PV_LD(A, 2); asm volatile("s_waitcnt lgkmcnt(8)" ::: "memory"); SBAR(); PV_MM(B, 1); SBAR();
    PV_LD(B, 3); asm volatile("s_waitcnt lgkmcnt(8)" ::: "memory"); SBAR(); PV_MM(A, 2); SBAR();
    asm volatile("s_waitcnt lgkmcnt(0)" ::: "memory"); SBAR(); PV_MM(B, 3);
#undef PV_MM
#undef PV_LD
#undef TRRD
}
__device__ __forceinline__ void pack_p(const f32x16& p0, const f32x16& p1, bf16x8& pa0, bf16x8& pa1, bf16x8& pa2, bf16x8& pa3) {
#define PK4(P, B_, OUT) do { unsigned a0 = cvtpk(P[B_+0], P[B_+1]), a1 = cvtpk(P[B_+2], P[B_+3]); unsigned b0 = cvtpk(P[B_+4], P[B_+5]), b1 = cvtpk(P[B_+6], P[B_+7]); \
        auto r0 = __builtin_amdgcn_permlane32_swap(a0, b0, false, false); auto r1 = __builtin_amdgcn_permlane32_swap(a1, b1, false, false); \
        u32x4 w = {r0[0], r1[0], r0[1], r1[1]}; OUT = *reinterpret_cast<bf16x8*>(&w); } while (0)
    PK4(p0, 0, pa0); PK4(p0, 8, pa1); PK4(p1, 0, pa2); PK4(p1, 8, pa3);
#undef PK4
}
__device__ __forceinline__ void mask_tile(f32x16& p0, f32x16& p1, int dq, unsigned W) {
    const float NEG = -__builtin_inff();
#pragma unroll
    for (int r = 0; r < 16; ++r) { const int c = (r & 3) + 8 * (r >> 2); if ((unsigned)(dq - c) >= W) p0[r] = NEG; if ((unsigned)(dq - c - 32) >= W) p1[r] = NEG; }
}
__device__ __forceinline__ void softmax_tile(f32x16& p0, f32x16& p1, float& m_reg, float& l_reg, float& alpha) {
    float pmax = p0[0];
#pragma unroll
    for (int r = 1; r < 16; ++r) pmax = fmaxf(pmax, p0[r]);
#pragma unroll
    for (int r = 0; r < 16; ++r) pmax = fmaxf(pmax, p1[r]);
    pmax = swap_max(pmax);
    const float mn = fmaxf(m_reg, pmax); alpha = ex2(m_reg - mn); m_reg = mn;
    float ps = 0.f;
#pragma unroll
    for (int r = 0; r < 16; ++r) { p0[r] = ex2(p0[r] - mn); ps += p0[r]; }
#pragma unroll
    for (int r = 0; r < 16; ++r) { p1[r] = ex2(p1[r] - mn); ps += p1[r]; }
    l_reg = l_reg * alpha + swap_sum(ps);
}
__device__ __forceinline__ void sb_tile(f32x16& p0, f32x16& p1, int dq, int hi, float& carry) {
    float s0[16], s1[16];
#pragma unroll
    for (int r = 0; r < 16; ++r) { const int c = (r & 3) + 8 * (r >> 2);
        { const float y = p0[r]; const float sp = fmaxf(y, 0.f) + lg2(1.f + ex2(-fabsf(y))); s0[r] = (dq - c) >= 0 ? sp : 0.f; }
        { const float y = p1[r]; const float sp = fmaxf(y, 0.f) + lg2(1.f + ex2(-fabsf(y))); s1[r] = (dq - c - 32) >= 0 ? sp : 0.f; } }
    float T0[4], T1[4], c0[4], c1[4];
#pragma unroll
    for (int g = 0; g < 4; ++g) {
        s0[4 * g + 2] += s0[4 * g + 3]; s0[4 * g + 1] += s0[4 * g + 2]; s0[4 * g] += s0[4 * g + 1]; T0[g] = s0[4 * g]; c0[g] = swap_sum(T0[g]);
        s1[4 * g + 2] += s1[4 * g + 3]; s1[4 * g + 1] += s1[4 * g + 2]; s1[4 * g] += s1[4 * g + 1]; T1[g] = s1[4 * g]; c1[g] = swap_sum(T1[g]); }
    float A1[4], A0[4]; A1[3] = 0.f; A1[2] = c1[3]; A1[1] = A1[2] + c1[2]; A1[0] = A1[1] + c1[1]; const float tot1 = A1[0] + c1[0];
    A0[3] = 0.f; A0[2] = c0[3]; A0[1] = A0[2] + c0[2]; A0[0] = A0[1] + c0[1]; const float tot0 = A0[0] + c0[0];
    const float base1 = carry, base0 = carry + tot1;
#pragma unroll
    for (int g = 0; g < 4; ++g) { const float ab1 = base1 + A1[g] + (hi == 0 ? c1[g] - T1[g] : 0.f), ab0 = base0 + A0[g] + (hi == 0 ? c0[g] - T0[g] : 0.f);
#pragma unroll
        for (int i = 0; i < 4; ++i) { const int r = 4 * g + i, c = (r & 3) + 8 * (r >> 2);
            p1[r] = (dq - c - 32) >= 0 ? ex2(p1[r] - (ab1 + s1[r])) : 0.f;
            p0[r] = (dq - c) >= 0 ? ex2(p0[r] - (ab0 + s0[r])) : 0.f; } }
    carry += tot1 + tot0;
}

struct PolCross { __device__ __forceinline__ int ntiles() const { return 4; } __device__ __forceinline__ int tile_base(int t) const { return 64 * t; } };
struct PolDil { int tb0, nt; __device__ __forceinline__ int ntiles() const { return nt; } __device__ __forceinline__ int tile_base(int t) const { return tb0 + 64 * t; } };
struct PolMoba { int own; __device__ __forceinline__ int ntiles() const { return 4 * (own + 1); } __device__ __forceinline__ int tile_base(int t) const { return 64 * t; } };
struct PolSB { int qi0; __device__ __forceinline__ int ntiles() const { return (qi0 + 256) >> 6; } __device__ __forceinline__ int tile_base(int t) const { return qi0 + 192 - 64 * t; } };
constexpr float SB_DONE = 48.f;

template <int MODE, class Pol>
__device__ __forceinline__ void attn_unit(LAS char* lds, const bf16* Qh, const bf16* Kh, const bf16* Vh, int stride, int res, int qi0, const Pol P,
                                          bf16* O, int opitch, float* L, const float* kmp  , const int wid) {
    const int lane_ = lane_id();
    const int lane = lane_, tid = wid * 64 + lane, r32 = lane & 31, hi = lane >> 5;
    LAS char* V_lds = lds + OFF_V; LAS char* K_lds = lds + OFF_K; LAS float* wsx = (LAS float*)(lds + OFF_WS) + wid * 64; LAS float* li_l = wsx; LAS float* al_l = wsx + 32;
    volatile LAS unsigned* flags = (volatile LAS unsigned*)(lds + OFF_FLAG);
    const int qw = qi0 + wid * 32;
    bf16x8 qr[8];
    { const bf16* qp = Qh + ((size_t)((qw + r32) * stride + res)) * HD + hi * 8;
#pragma unroll
      for (int d0 = 0; d0 < 8; ++d0) qr[d0] = *(const bf16x8*)(qp + d0 * 16); }
    const int sr = tid >> 4, sc = (tid & 15) * 8, vst0 = v_st(sr, sc), vst1 = v_st(32 + sr, sc), kws = kswz(sr, sc * 2);
    const unsigned vb0 = (unsigned)(size_t)lds + v_rd_base(lane);
    bf16x8 st_k0, st_k1, st_v0, st_v1;
#define TLOAD(t) do { const int tb_ = P.tile_base(t); const size_t a0_ = ((size_t)((tb_ + sr) * stride + res)) * HD + sc, a1_ = ((size_t)((tb_ + 32 + sr) * stride + res)) * HD + sc; \
        st_k0 = *(const bf16x8*)(Kh + a0_); st_k1 = *(const bf16x8*)(Kh + a1_); st_v0 = *(const bf16x8*)(Vh + a0_); st_v1 = *(const bf16x8*)(Vh + a1_); } while (0)
#define TWRITE(bf) do { *(LAS bf16x8*)(K_lds + (bf) * SHM + kws) = st_k0; *(LAS bf16x8*)(K_lds + (bf) * SHM + kws + 32 * 256) = st_k1; \
        *(LAS bf16x8*)(V_lds + (bf) * SHM + vst0) = st_v0; *(LAS bf16x8*)(V_lds + (bf) * SHM + vst1) = st_v1; } while (0)
    const int NT = P.ntiles();
    unsigned selbits = 0u;
    TLOAD(0);
    if constexpr (MODE == 2) {
        { const int row = tid >> 4, blk = row & 15, lo = row >> 4; const float* km = kmp + (size_t)blk * 2 * HD + sc; float v[8];
#pragma unroll
          for (int i = 0; i < 8; ++i) { v[i] = (km[i] + km[HD + i]) * (1.f / 256.f); const float h = __uint_as_float(f2bf(v[i]) << 16); v[i] = lo ? v[i] - h : h; }
          u32x4 w; w.x = pk2(v[0], v[1]); w.y = pk2(v[2], v[3]); w.z = pk2(v[4], v[5]); w.w = pk2(v[6], v[7]);
          *(LAS u32x4*)(K_lds + kswz(row, sc * 2)) = w; }
        __syncthreads();
        f32x16 g0, g1; qkt<0, false>(g0, g1, K_lds, r32, hi, qr);
        float gown[8], goth[8];
#pragma unroll
        for (int r = 0; r < 8; ++r) { gown[r] = g0[r] + g0[r + 8]; goth[r] = get_xor32(gown[r], hi); }
        float g16[16];
#pragma unroll
        for (int a = 0; a < 2; ++a)
#pragma unroll
            for (int h2 = 0; h2 < 2; ++h2)
#pragma unroll
                for (int i = 0; i < 4; ++i) { const int blk = 8 * a + 4 * h2 + i; const float v = (h2 == hi) ? gown[4 * a + i] : goth[4 * a + i]; g16[blk] = blk < P.own ? v : -__builtin_inff(); }
#pragma unroll
        for (int rk = 0; rk < 3; ++rk) { float best = -__builtin_inff(); int bi = -1;
#pragma unroll
            for (int j = 0; j < 16; ++j) if (g16[j] > best) { best = g16[j]; bi = j; }
#pragma unroll
            for (int j = 0; j < 16; ++j) if (j == bi) g16[j] = -__builtin_inff();
            if (bi >= 0) selbits |= 1u << bi; }
        __syncthreads();
    }
    TWRITE(0);
    __syncthreads();
    float m_reg = -1e30f, l_reg = 0.f, carry = 0.f; f32x16 o[4];
    { float z = 0.f; asm volatile("" : "+v"(z));
#pragma unroll
      for (int r = 0; r < 16; ++r) { o[0][r] = z; o[1][r] = z; o[2][r] = z; o[3][r] = z; } }
    bool done = false;
#define STEP(t, B) do { const int tb = P.tile_base(t); const bool more = (t) + 1 < NT; \
        if (more) TLOAD((t) + 1); \
        bool act = true; \
        if (MODE == 1) act = (tb <= qw + 31) && (tb + 63 >= qw - 128); \
        if constexpr (MODE == 2) { const int blk = (t) >> 2; act = blk < P.own ? (__any((selbits >> blk) & 1u) != 0) : (tb <= qw + 31); } \
        if (MODE == 3) act = (tb <= qw + 30) && !done; \
        if (act) { f32x16 p0, p1; qkt<B, true>(p0, p1, K_lds, r32, hi, qr); bf16x8 pa0, pa1, pa2, pa3; \
            if (MODE == 3) { sb_tile(p0, p1, qw + r32 - 1 - tb - 4 * hi, hi, carry); done = __all(carry > SB_DONE) != 0; } \
            else { \
                if (MODE == 1) mask_tile(p0, p1, qw + r32 - tb - 4 * hi, 129u); \
                if constexpr (MODE == 2) { const int blk = (t) >> 2; if (blk < P.own) { if (!((selbits >> blk) & 1u)) { const float NEG = -__builtin_inff(); _Pragma("unroll") for (int r = 0; r < 16; ++r) { p0[r] = NEG; p1[r] = NEG; } } } \
                                 else if (tb + 63 > qw) mask_tile(p0, p1, qw + r32 - tb - 4 * hi, 0x40000000u); } \
                float alpha; softmax_tile(p0, p1, m_reg, l_reg, alpha); \
                if (__any(alpha < 1.f)) { if (hi == 0) al_l[r32] = alpha; asm volatile("s_waitcnt lgkmcnt(0)" ::: "memory"); \
                    _Pragma("unroll") for (int r = 0; r < 16; ++r) { const float a_ = al_l[crow(r, hi)]; o[0][r] *= a_; o[1][r] *= a_; o[2][r] *= a_; o[3][r] *= a_; } } } \
            pack_p(p0, p1, pa0, pa1, pa2, pa3); SBAR(); pv_tile<B>(o, vb0, pa0, pa1, pa2, pa3); } \
        if (more) TWRITE((B) ^ 1); \
        if (MODE == 3 && lane == 0) flags[(B) * 8 + wid] = done ? 1u : 0u; \
        __syncthreads(); } while (0)
    for (int t = 0; t < NT; t += 2) {
        STEP(t, 0);
        if (MODE == 3) { unsigned f = 1u; _Pragma("unroll") for (int w = 0; w < 8; ++w) f &= flags[w]; if (f) break; }
        if (t + 1 < NT) { STEP(t + 1, 1);
            if (MODE == 3) { unsigned f = 1u; _Pragma("unroll") for (int w = 0; w < 8; ++w) f &= flags[8 + w]; if (f) break; } }
    }
#undef STEP
#undef TLOAD
#undef TWRITE
    float rli[16];
    if (MODE != 3) { if (hi == 0) li_l[r32] = l_reg; asm volatile("s_waitcnt lgkmcnt(0)" ::: "memory");
#pragma unroll
        for (int r = 0; r < 16; ++r) rli[r] = __builtin_amdgcn_rcpf(li_l[crow(r, hi)]); }
    if (MODE == 0 && CO_FP8) {
#pragma unroll
        for (int r = 0; r < 16; ++r) { const int qi = qw + crow(r, hi); unsigned char* orow = (unsigned char*)O + (size_t)(qi * stride + res) * opitch;
#pragma unroll
            for (int d0 = 0; d0 < 4; ++d0) { const float a = o[d0][r] * rli[r], b = xor_lane<1>(a), a2 = xor_lane<2>(a), b2 = xor_lane<2>(b);
                if ((r32 & 3) == 0) *(unsigned*)(orow + d0 * 32 + r32) = pk4f8(a, b, a2, b2); } }
    } else {
#pragma unroll
    for (int r = 0; r < 16; ++r) { const int qi = qw + crow(r, hi); bf16* orow = O + (size_t)(qi * stride + res) * opitch;
#pragma unroll
        for (int d0 = 0; d0 < 4; ++d0) { const float v = MODE != 3 ? o[d0][r] * rli[r] : o[d0][r]; const float vn = xor_lane<1>(v);
            if ((r32 & 1) == 0) *(unsigned*)(orow + d0 * 32 + r32) = cvtpk(v, vn); } }
    }
    if (MODE == 1 && hi == 0) L[(size_t)((qw + r32) * stride + res) * 2] = m_reg + lg2(l_reg);
    asm volatile("s_waitcnt lgkmcnt(0)" ::: "memory"); __builtin_amdgcn_s_barrier();
}

#if MOBA_GATHER
constexpr int RES_WS = 133120;
__device__ __forceinline__ void moba_gates(LAS char* lds, const bf16* Qh, const float* kmp, const int qb, unsigned* sel, unsigned short* list, unsigned* cnt, const int wid) {
    const int lane_ = lane_id();
    const int lane = lane_, tid = wid * 64 + lane, r32 = lane & 31, hi = lane >> 5;
    LAS char* K_lds = lds + OFF_K; LAS unsigned* cw = (LAS unsigned*)(lds + OFF_WS);
    const int qw = qb * 256 + wid * 32, sc = (tid & 15) * 8;
    bf16x8 qr[8];
    { const bf16* qp = Qh + (size_t)(qw + r32) * HD + hi * 8;
#pragma unroll
      for (int d0 = 0; d0 < 8; ++d0) qr[d0] = *(const bf16x8*)(qp + d0 * 16); }
    { const int row = tid >> 4, blk = row & 15, lo = row >> 4; const float* km = kmp + (size_t)blk * 2 * HD + sc; float v[8];
#pragma unroll
      for (int i = 0; i < 8; ++i) { v[i] = (km[i] + km[HD + i]) * (1.f / 256.f); const float h = __uint_as_float(f2bf(v[i]) << 16); v[i] = lo ? v[i] - h : h; }
      u32x4 w; w.x = pk2(v[0], v[1]); w.y = pk2(v[2], v[3]); w.z = pk2(v[4], v[5]); w.w = pk2(v[6], v[7]);
      *(LAS u32x4*)(K_lds + kswz(row, sc * 2)) = w; }
    __syncthreads();
    unsigned selbits = 0u;
    { f32x16 g0, g1; qkt<0, false>(g0, g1, K_lds, r32, hi, qr);
      float gown[8], goth[8];
#pragma unroll
      for (int r = 0; r < 8; ++r) { gown[r] = g0[r] + g0[r + 8]; goth[r] = get_xor32(gown[r], hi); }
      float g16[16];
#pragma unroll
      for (int a = 0; a < 2; ++a)
#pragma unroll
          for (int h2 = 0; h2 < 2; ++h2)
#pragma unroll
              for (int i = 0; i < 4; ++i) { const int blk = 8 * a + 4 * h2 + i; const float v = (h2 == hi) ? gown[4 * a + i] : goth[4 * a + i]; g16[blk] = blk < qb ? v : -__builtin_inff(); }
#pragma unroll
      for (int rk = 0; rk < 3; ++rk) { float best = -__builtin_inff(); int bi = -1;
#pragma unroll
          for (int j = 0; j < 16; ++j) if (g16[j] > best) { best = g16[j]; bi = j; }
#pragma unroll
          for (int j = 0; j < 16; ++j) if (j == bi) g16[j] = -__builtin_inff();
          if (bi >= 0) selbits |= 1u << bi; } }
    const bool mine = hi == 0;
    if (mine) sel[qw + r32] = selbits;
#pragma unroll 1
    for (int j = 0; j < 16; ++j) { const unsigned long long m = __ballot(mine && ((selbits >> j) & 1u)); if (lane == 0) cw[wid * 16 + j] = (unsigned)__popcll(m); }
    __syncthreads();
#pragma unroll 1
    for (int j = 0; j < 16; ++j) { const bool bit = mine && ((selbits >> j) & 1u); const unsigned long long m = __ballot(bit); unsigned base = 0u;
#pragma unroll
        for (int w = 0; w < 8; ++w) base += w < wid ? cw[w * 16 + j] : 0u;
        if (bit) list[(size_t)(j * 16 + qb) * 256 + base + (unsigned)__popcll(m & ((1ull << r32) - 1ull))] = (unsigned short)(qw + r32); }
    if (wid == 0 && lane < 16) { unsigned t = 0u;
#pragma unroll
        for (int w = 0; w < 8; ++w) t += cw[w * 16 + lane];
        cnt[lane * 16 + qb] = t; }
    __syncthreads();
}
__device__ __forceinline__ void moba_unit(LAS char* lds, const bf16* Qh, const bf16* Kh, const bf16* Vh, const int j, const int k, const unsigned* cnt, const unsigned short* list, const unsigned* sel, bf16* P0, float* L0, const int wid) {
    const int lane_ = lane_id();
    const int lane = lane_, tid = wid * 64 + lane, r32 = lane & 31, hi = lane >> 5;
    const int cv = (lane > j && lane < 16) ? (int)cnt[lane] : 0;
    int total = 0;
#pragma unroll
    for (int q = 1; q < 16; ++q) total += __builtin_amdgcn_readlane(cv, q);
    const int nch = total > 512 ? (total + 511) >> 9 : 1;
    if (k >= nch) { asm volatile("s_waitcnt lgkmcnt(0)" ::: "memory"); __builtin_amdgcn_s_barrier(); return; }
    LAS char* K_lds = lds + 4 * SHM;
    { const int sr = tid >> 4, sc = (tid & 15) * 8, vst0 = v_st(sr, sc), vst1 = v_st(32 + sr, sc), kws = kswz(sr, sc * 2);
      const size_t a0 = (size_t)(256 * j + sr) * HD + sc; bf16x8 kk[4][2], vv[4][2];
#pragma unroll
      for (int t = 0; t < 4; ++t) { kk[t][0] = *(const bf16x8*)(Kh + a0 + (size_t)(64 * t) * HD); kk[t][1] = *(const bf16x8*)(Kh + a0 + (size_t)(64 * t + 32) * HD);
          vv[t][0] = *(const bf16x8*)(Vh + a0 + (size_t)(64 * t) * HD); vv[t][1] = *(const bf16x8*)(Vh + a0 + (size_t)(64 * t + 32) * HD); }
#pragma unroll
      for (int t = 0; t < 4; ++t) { *(LAS bf16x8*)(K_lds + t * SHM + kws) = kk[t][0]; *(LAS bf16x8*)(K_lds + t * SHM + kws + 32 * 256) = kk[t][1];
          *(LAS bf16x8*)(lds + t * SHM + vst0) = vv[t][0]; *(LAS bf16x8*)(lds + t * SHM + vst1) = vv[t][1]; } }
    __syncthreads();
    const unsigned vb0 = (unsigned)(size_t)lds + v_rd_base(lane);
    LAS unsigned* rinfo = (LAS unsigned*)(lds + RES_WS) + wid * 128; LAS float* li_l = (LAS float*)(rinfo + 32); LAS float* al_l = li_l + 32;
    const int lo = k << 9, rem = total - lo, nl = rem < 0 ? 0 : (rem < 512 ? rem : 512), ngl = (nl + 31) >> 5, ng = ngl + (k == nch - 1 ? 8 : 0);
#define LOOKUP(G, SROW, VALID) do { if ((G) < ngl) { const int p_ = ((G) << 5) + r32, pp_ = lo + p_; VALID = p_ < nl; int acc_ = 0, seg_ = 0, off_ = 0; \
            _Pragma("unroll") for (int q = 1; q < 16; ++q) { const int c_ = __builtin_amdgcn_readlane(cv, q); if (pp_ >= acc_ && pp_ < acc_ + c_) { seg_ = q; off_ = pp_ - acc_; } acc_ += c_; } \
            SROW = VALID ? (int)list[seg_ * 256 + off_] : 256 * j; } \
        else { SROW = 256 * j + ((G) - ngl) * 32 + r32; VALID = true; } } while (0)
#define QLOAD(SROW) do { const bf16* qp_ = Qh + (size_t)(SROW) * HD + hi * 8; _Pragma("unroll") for (int d0 = 0; d0 < 8; ++d0) qr[d0] = *(const bf16x8*)(qp_ + d0 * 16); } while (0)
    int g = wid, srow = 256 * j; bool valid = false; unsigned selw = 0u; bf16x8 qr[8];
    if (g < ng) { LOOKUP(g, srow, valid); selw = sel[srow]; QLOAD(srow); }
#pragma unroll 1
    while (g < ng) {
        const bool ownq = g >= ngl; const int qo = (g - ngl) * 32, gn = g + 8;
        int srow_n = 256 * j; bool valid_n = false; unsigned selw_n = 0u;
        if (gn < ng) LOOKUP(gn, srow_n, valid_n);
        float m_reg = -1e30f, l_reg = 0.f; f32x16 o[4];
        { float z = 0.f; asm volatile("" : "+v"(z));
#pragma unroll
          for (int r = 0; r < 16; ++r) { o[0][r] = z; o[1][r] = z; o[2][r] = z; o[3][r] = z; } }
#define RTAIL(B) do { bf16x8 pa0, pa1, pa2, pa3; \
                if (ownq && 64 * (B) + 63 > qo) mask_tile(p0, p1, qo + r32 - 64 * (B) - 4 * hi, 0x40000000u); \
                float alpha; softmax_tile(p0, p1, m_reg, l_reg, alpha); \
                if ((B) > 0 && __any(alpha < 1.f)) { if (hi == 0) al_l[r32] = alpha; asm volatile("s_waitcnt lgkmcnt(0)" ::: "memory"); \
                    _Pragma("unroll") for (int r = 0; r < 16; ++r) { const float a_ = al_l[crow(r, hi)]; o[0][r] *= a_; o[1][r] *= a_; o[2][r] *= a_; o[3][r] *= a_; } } \
                pack_p(p0, p1, pa0, pa1, pa2, pa3); SBAR(); pv_tile<B>(o, vb0, pa0, pa1, pa2, pa3); } while (0)
#define RTILE(B) do { if (!ownq || (64 * (B) <= qo + 31)) { f32x16 p0, p1; qkt<B, true>(p0, p1, K_lds, r32, hi, qr); RTAIL(B); } } while (0)
        RTILE(0); RTILE(1); RTILE(2);
        { const bool act3 = !ownq || (192 <= qo + 31); f32x16 p0, p1;
          if (act3) qkt<3, true>(p0, p1, K_lds, r32, hi, qr);
          const unsigned info = (unsigned)srow | ((ownq ? 3u : (unsigned)__popc(selw & ((1u << j) - 1u))) << 16) | ((valid ? 1u : 0u) << 20);
          if (hi == 0) rinfo[r32] = info;
          if (gn < ng) { selw_n = sel[srow_n]; QLOAD(srow_n); }
          if (act3) RTAIL(3);
          if (hi == 0) li_l[r32] = l_reg; asm volatile("s_waitcnt lgkmcnt(0)" ::: "memory");
#pragma unroll
          for (int r = 0; r < 16; ++r) { const int rr = crow(r, hi); const unsigned inf = rinfo[rr]; const float rl = __builtin_amdgcn_rcpf(li_l[rr]); const bool ok = ((inf >> 20) & 1u) != 0u;
              bf16* orow = P0 + (size_t)((inf >> 16) & 15u) * ((size_t)M * 512) + (size_t)(inf & 0xffffu) * 512;
#pragma unroll
              for (int d0 = 0; d0 < 4; ++d0) { const float v = o[d0][r] * rl; const float vn = xor_lane<1>(v); if (ok && (r32 & 1) == 0) *(unsigned*)(orow + d0 * 32 + r32) = cvtpk(v, vn); } }
          if (hi == 0 && valid) { L0[((size_t)((info >> 16) & 15u) * M + srow) * 4] = m_reg + lg2(l_reg);
              if (ownq) { for (int sl = j; sl < 3; ++sl) L0[((size_t)sl * M + srow) * 4] = -__builtin_inff(); } } }
#undef RTILE
#undef RTAIL
        g = gn; srow = srow_n; valid = valid_n; selw = selw_n;
    }
#undef LOOKUP
#undef QLOAD
    asm volatile("s_waitcnt lgkmcnt(0)" ::: "memory"); __builtin_amdgcn_s_barrier();
}
#endif
}

__device__ __forceinline__ void fast_attention(Frame& F, unsigned* qctr, const int n_ckv) {
    const bf16 *Q = (const bf16*)(F.ws + WS_Q), *K = (const bf16*)(F.ws + WS_K), *V = (const bf16*)(F.ws + WS_V);
    bf16 *OA = (bf16*)(F.ws + WS_OA), *OB = (bf16*)(F.ws + WS_OB), *OC = (bf16*)(F.ws + WS_OC); float* LSE = (float*)(F.ws + WS_LSE); const float* KMP = (const float*)(F.ws + WS_KMP);
    LAS char* lds = (LAS char*)F.lds; volatile LAS unsigned* slot = (volatile LAS unsigned*)(lds + att::OFF_SLOT);
    unsigned nxt = 0u;
    if (F.wave == 0 && lane_id() == 0) nxt = __hip_atomic_fetch_add(qctr, 1u, __ATOMIC_RELAXED, __HIP_MEMORY_SCOPE_AGENT);
    for (;;) {
        if (F.wave == 0 && lane_id() == 0) *slot = nxt;
        asm volatile("s_waitcnt lgkmcnt(0)" ::: "memory"); __builtin_amdgcn_s_barrier();
        const int uq = (int)__builtin_amdgcn_readfirstlane(*slot);
        if (F.wave == 0 && lane_id() == 0) nxt = __hip_atomic_fetch_add(qctr, 1u, __ATOMIC_RELAXED, __HIP_MEMORY_SCOPE_AGENT);
        if (uq < n_ckv) { pg8::Gemm g{(const bf16*)(F.ws + WS_MEMN), (const bf16*)(F.ws + WS_WCKV), MROWS, DEPTH * 2 * CW, DM}; pg8::OneUnit S{uq & 3, uq >> 2};
            pg8::EpiOut<2> E{nullptr, (bf16*)(F.ws + WS_CK), 1.f, (WS_CV - WS_CK) / 2};
            pg8::gemm_phase<pg8::EpiOut<2>, pg8::OneUnit, true, true>(F.lds, g, S, E, F.wave); __syncthreads(); continue; }
#if MOBA_GATHER
        int u = uq - n_ckv;
        constexpr int NMOBA = 65 * 16;
        if (u >= NMOBA + 768) break;
        if (u < NMOBA) { int r = u >> 4, k = 0, nj = 16; const int bh = u & 15, b = bh >> 2, h = bh & 3; const size_t hb = (size_t)(b * 16 + h) * SEQ * HD;
            while (r >= nj) { r -= nj; ++k; nj = 15 - 2 * k; }
            const int j = r;
            att::moba_unit(lds, Q + hb, K + hb, V + hb, j, k, (const unsigned*)(F.ws + WS_CNT) + (bh * 16 + j) * 16, (const unsigned short*)(F.ws + WS_LIST) + (size_t)(bh * 16 + j) * 16 * 256,
                           (const unsigned*)(F.ws + WS_SEL) + bh * SEQ, (bf16*)(F.ws + WS_PART) + (size_t)b * SEQ * 512 + h * HD, (float*)(F.ws + WS_PLSE) + (size_t)b * SEQ * 4 + h, F.wave);
            continue; }
        u -= NMOBA - 256;
        if (false) {}
#else
        const int u = uq - n_ckv;
        if (u >= 1024) break;
        if (u < 256) { const int own = 15 - (u >> 4), bh = u & 15, b = bh >> 2, h = bh & 3; const size_t hb = (size_t)(b * 16 + h) * SEQ * HD;
            att::attn_unit<2>(lds, Q + hb, K + hb, V + hb, 1, 0, own * 256, att::PolMoba{own}, OA + (size_t)b * SEQ * 512 + h * HD, 512, nullptr, KMP + (size_t)bh * 16 * 2 * HD, F.wave); }
#endif
        else if (u < 640) { const int v = u - 256, bh6 = v % 24, qb = 15 - v / 24, b = bh6 / 6, h = 4 + bh6 % 6; const size_t hb = (size_t)(b * 16 + h) * SEQ * HD;
            att::attn_unit<3>(lds, Q + hb, K + hb, V + hb, 1, 0, qb * 256, att::PolSB{qb * 256}, OB + (size_t)b * SEQ * 768 + (h - 4) * HD, 768, nullptr, nullptr, F.wave); }
        else { const int v = u - 640, bh6 = v % 24, idx = v / 24, b = bh6 / 6, hc = bh6 % 6, g = hc >> 1, jj = hc & 1, sh = 2 * g, d = 1 << sh, nqb = 16 >> sh, res = idx / nqb, qi0 = (idx % nqb) * 256;
            const size_t hb = (size_t)(b * 16 + 10 + hc) * SEQ * HD; const int tb0 = qi0 >= 128 ? qi0 - 128 : 0;
            att::attn_unit<1>(lds, Q + hb, K + hb, V + hb, d, res, qi0, att::PolDil{tb0, (qi0 + 256 - tb0) >> 6}, OC + ((size_t)g * M + (size_t)b * SEQ) * 256 + jj * HD, 256, LSE + ((size_t)g * M + (size_t)b * SEQ) * 2 + jj, nullptr, F.wave); }
    }
}
#if MOBA_GATHER
static_assert(OUT_I8, "the MoBA partial merge lives in the int8 branch of phase_merge");
__device__ __forceinline__ void phase_gates(Frame& F) {
    const bf16* Q = (const bf16*)(F.ws + WS_Q); const float* KMP = (const float*)(F.ws + WS_KMP);
    for (int u = blockIdx.x; u < 256; u += gridDim.x) { const int bh = u >> 4, qb = u & 15, b = bh >> 2, h = bh & 3;
        att::moba_gates((LAS char*)F.lds, Q + (size_t)(b * 16 + h) * SEQ * HD, KMP + (size_t)bh * 16 * 2 * HD, qb, (unsigned*)(F.ws + WS_SEL) + bh * SEQ,
                        (unsigned short*)(F.ws + WS_LIST) + (size_t)bh * 16 * 16 * 256, (unsigned*)(F.ws + WS_CNT) + bh * 256, F.wave); }
}
#endif
__device__ __forceinline__ void fast_xattn(Frame& F, int layer) {
    const bf16 *QC = (const bf16*)(F.ws + WS_QC), *CK = (const bf16*)(F.ws + WS_CK), *CV = (const bf16*)(F.ws + WS_CV); bf16* OCR = (bf16*)(F.ws + WS_OCR);
    for (int u = blockIdx.x; u < 256; u += gridDim.x) { const int bh = u >> 4, qb = u & 15, b = bh >> 2, h = bh & 3; const size_t kb = ((size_t)(layer * 4 + b) * 4 + h) * MEML * HD;
        att::attn_unit<0>((LAS char*)F.lds, QC + (size_t)bh * SEQ * HD, CK + kb, CV + kb, 1, 0, qb * 256, att::PolCross{}, CO_FP8 ? (bf16*)((unsigned char*)OCR + (size_t)b * SEQ * CW + h * HD) : OCR + (size_t)b * SEQ * CW + h * HD, CW, nullptr, nullptr, F.wave); }
}

#define XB_TMO      128
#define XB_XCNT(j)  (256  + 64 * (j))
#define XB_XSUB(j)  (1280 + 64 * (j))
#define XB_XGEN(j)  (2304 + 64 * (j))
#define XB_TOP      3328
#define XB_TOPGEN   3392
#define XCD_BAR_WORDS 3456
#define XB_SPIN_CAP (1u << 18)

__device__ __forceinline__ unsigned xb_ld(unsigned* p)              { return __hip_atomic_load(p, __ATOMIC_RELAXED, __HIP_MEMORY_SCOPE_AGENT); }
__device__ __forceinline__ unsigned xb_add(unsigned* p, unsigned v) { return __hip_atomic_fetch_add(p, v, __ATOMIC_RELAXED, __HIP_MEMORY_SCOPE_AGENT); }
__device__ __forceinline__ unsigned xb_xcc_id() { return (unsigned)__builtin_amdgcn_s_getreg((3 << 11) | 20) & 0xFu; }
#define XB_SPIN(cond, bar) do { unsigned _sp = 0; while (cond) { __builtin_amdgcn_s_sleep(1); \
    if ((++_sp & 255u) == 0u) { if (xb_ld(&(bar)[XB_TMO])) break; if (_sp > XB_SPIN_CAP) { atomicAdd(&(bar)[XB_TMO], 1u); break; } } } } while (0)

struct XcdBarrier {
    unsigned* bar; unsigned x;
    volatile LAS unsigned* st;
};

__device__ __forceinline__ XcdBarrier xcd_barrier_post(unsigned* bar, volatile LAS unsigned* st) {
    XcdBarrier b; b.bar = bar; b.x = xb_xcc_id(); b.st = st;
    if (threadIdx.x == 0) (void)xb_add(&bar[XB_XCNT(b.x)], 1u);
    return b;
}
__device__ __forceinline__ void xcd_barrier_complete(unsigned* bar, unsigned x, unsigned& nloc, unsigned& nx) {
    const unsigned G = gridDim.x * gridDim.y * gridDim.z;
    unsigned sum, cnt, mine, sp = 0u;
    for (;;) {
        sum = 0u; cnt = 0u; mine = 0u;
#pragma unroll
        for (unsigned j = 0; j < 16; ++j) { const unsigned c = xb_ld(&bar[XB_XCNT(j)]); sum += c; cnt += (c > 0u) ? 1u : 0u; mine = (j == x) ? c : mine; }
        if (sum == G) break;
        __builtin_amdgcn_s_sleep(1);
        if ((++sp & 255u) == 0u) { if (xb_ld(&bar[XB_TMO])) break; if (sp > XB_SPIN_CAP) { atomicAdd(&bar[XB_TMO], 1u); break; } }
    }
    nloc = mine > 0u ? mine : 1u; nx = cnt > 0u ? cnt : 1u;
}

__device__ __forceinline__ void xcd_barrier(const XcdBarrier& b) {
    asm volatile("s_waitcnt vmcnt(0)" ::: "memory");
    __syncthreads();
    if (threadIdx.x == 0) {
        unsigned* bar = b.bar;
        __builtin_amdgcn_s_waitcnt(0);
        unsigned nloc = b.st[0], nx = b.st[1];
        if (nloc == 0u) { xcd_barrier_complete(bar, b.x, nloc, nx); b.st[0] = nloc; b.st[1] = nx; }
        const unsigned old = xb_add(&bar[XB_XSUB(b.x)], 1u);
        const unsigned gen = old / nloc;
        if (old + 1u == (gen + 1u) * nloc) {
            __builtin_amdgcn_fence(__ATOMIC_RELEASE, "agent");
            asm volatile("s_waitcnt vmcnt(0)" ::: "memory");
            const unsigned og = xb_add(&bar[XB_TOP], 1u);
            const unsigned tg = og / nx;
            if (og + 1u == (tg + 1u) * nx) xb_add(&bar[XB_TOPGEN], 1u);
            else XB_SPIN(xb_ld(&bar[XB_TOPGEN]) == tg, bar);
            __builtin_amdgcn_fence(__ATOMIC_ACQUIRE, "agent");
            xb_add(&bar[XB_XGEN(b.x)], 1u);
            asm volatile("s_waitcnt vmcnt(0)" ::: "memory");
        } else {
            XB_SPIN(xb_ld(&bar[XB_XGEN(b.x)]) == gen, bar);
            __builtin_amdgcn_fence(__ATOMIC_ACQUIRE, "agent");
            asm volatile("s_waitcnt vmcnt(0)" ::: "memory");
        }
    }
    __syncthreads();
}

#ifndef MK_ONE_LAUNCH
#define MK_ONE_LAUNCH 1
#endif
#ifndef FAST_QKV
#define FAST_QKV 1
#endif
#ifndef FAST_RES
#define FAST_RES 1
#endif
#ifndef FAST_CQ
#define FAST_CQ 1
#endif
#ifndef FAST_UP
#define FAST_UP 1
#endif
#ifndef FAST_CKV
#define FAST_CKV 1
#endif
#ifndef FAST_ATT
#define FAST_ATT 1
#endif
#ifndef FAST_XATT
#define FAST_XATT 1
#endif
__global__ void __launch_bounds__(NTHREADS, 2) mk_fwd(Args args) {
    extern __shared__ __attribute__((aligned(16))) unsigned char lds[];
    Frame F; F.lds = (LAS unsigned char*)lds; F.lane = threadIdx.x & 63; F.wave = __builtin_amdgcn_readfirstlane(threadIdx.x >> 6);
    F.gw = blockIdx.x * NWAVES + F.wave; F.ngw = gridDim.x * NWAVES; F.X = args.out; F.ws = args.ws;
    const int lo = args.ph_lo, hi = args.ph_hi;
    volatile LAS unsigned* MISC = (volatile LAS unsigned*)(F.lds + MISC_OFF);
    for (int u = threadIdx.x; u < 64; u += NTHREADS) MISC[u] = 0u;
    __syncthreads();
    XcdBarrier bar; bar.bar = (unsigned*)(args.ws + WS_CTL) + CW_BAR; bar.x = 0; bar.st = nullptr;
    if (hi - lo > 1) bar = xcd_barrier_post((unsigned*)(args.ws + WS_CTL) + CW_BAR, MISC + 8);
#define IN(k) (lo <= (k) && (k) < hi)
#define SEAM(k) do { if (IN(k) && (k) + 1 < hi) xcd_barrier(bar); } while (0)
#define ENTER() do { F.lane = lane_id(); } while (0)
    unsigned char* ws = args.ws;
    const float* ssp = (const float*)(ws + WS_SSP);
    if (IN(PH_PRO0)) phase_pro0(F, args);
    SEAM(PH_PRO0);
#define BFP(off) ((bf16*)(ws + (off)))
    if (IN(PH_PRO1) && !(FAST_CKV && FAST_ATT)) {
#if FAST_CKV
        pg8::Gemm g{BFP(WS_MEMN), BFP(WS_WCKV), MROWS, DEPTH * 2 * CW, DM}; pg8::StaticOrder S; S.init(MROWS, DEPTH * 2 * CW, (int)gridDim.x, (int)blockIdx.x);
        pg8::EpiOut<2> E{nullptr, BFP(WS_CK), 1.f, (WS_CV - WS_CK) / 2};
        pg8::gemm_phase<pg8::EpiOut<2>, pg8::StaticOrder, true, true>(F.lds, g, S, E, F.wave);
#else
        NEpiCkv E{BFP(WS_CK)}; ngemm(F, BFP(WS_MEMN), BFP(WS_WCKV), MROWS, DEPTH * 2 * CW, DM, E);
#endif
    }
    if (!(FAST_CKV && FAST_ATT)) SEAM(PH_PRO1);
    for (int l = 0; l < DEPTH; ++l) {
        const int pb = PH_L0 + PH_PER_LAYER * l;
        if (IN(pb + LP_QKV)) {
#if FAST_QKV
            { pg8::Gemm g{BFP(WS_XB), BFP(WS_WIN) + (size_t)l * NQKV * DM, M, V_FP8 ? 2 * DM : NQKV, DM}; pg8::StaticOrder S; S.init(M, V_FP8 ? 2 * DM : NQKV, (int)gridDim.x, (int)blockIdx.x);
              pg8::rstd_table(F.lds, ssp, S, F.wave);
              pg8::EpiQKV E{(const LAS float*)(F.lds + pg8::RTAB_OFF), (const float*)(ws + WS_ROPE), (const float*)(ws + WS_ROPE) + SEQ * 64, BFP(WS_Q), (WS_K - WS_Q) / 2, (float*)(ws + WS_KMP), C2, 0, 1.f};
              pg8::gemm_phase<pg8::EpiQKV, pg8::StaticOrder, true, true>(F.lds, g, S, E, F.wave); }
#if MOBA_GATHER
        }
        SEAM(pb + LP_QKV);
        if (IN(pb + LP_KM)) { ENTER(); phase_gates(F);
#endif
#if V_FP8
            { pg8::Gemm g{BFP(WS_XB8), BFP(WS_WV8 + (size_t)l * DM * DM), M, DM, DM}; pg8::StaticOrder S; S.init(M, DM, (int)gridDim.x, (int)blockIdx.x);
              pg8::rstd_table(F.lds, ssp, S, F.wave);
              pg8::EpiQKV E{(const LAS float*)(F.lds + pg8::RTAB_OFF), (const float*)(ws + WS_ROPE), (const float*)(ws + WS_ROPE) + SEQ * 64, BFP(WS_Q), (WS_K - WS_Q) / 2, (float*)(ws + WS_KMP), C2, 2, 1.f / W8_V_SCALE};
              pg8::gemm_phase<pg8::EpiQKV, pg8::StaticOrder, true, true, true>(F.lds, g, S, E, F.wave); }
#endif
#else
            NEpiQKV E{ssp, (const float*)(ws + WS_ROPE), (const float*)(ws + WS_ROPE) + SEQ * 64, BFP(WS_Q)};
            ngemm(F, BFP(WS_XB), BFP(WS_WIN) + (size_t)l * NQKV * DM, M, NQKV, DM, E);
#endif
        }
#if MOBA_GATHER
        SEAM(pb + LP_KM);
#else
        SEAM(pb + LP_QKV);
#endif
#if !FAST_QKV
        if (IN(pb + LP_KM)) { ENTER(); naive_kmean(F); }
        SEAM(pb + LP_KM);
#endif
        if (IN(pb + LP_ATT)) { ENTER();
#if FAST_ATT
            fast_attention(F, (unsigned*)(ws + WS_CTL) + 64 * (1 + l), (FAST_CKV && l == 0) ? (MROWS / 256) * (DEPTH * 2 * CW / 256) : 0);
#else
            naive_attention(F);
#endif
        }
        SEAM(pb + LP_ATT);
        if (IN(pb + LP_MRG)) { ENTER(); phase_merge(F); }
        SEAM(pb + LP_MRG);
        if (IN(pb + LP_OUT)) {
#if FAST_RES
            pg8::Gemm g{BFP(WS_MRG), OUT_I8 ? BFP(WS_WOUT + (size_t)l * DM * OW) : BFP(WS_WOUT) + (size_t)l * DM * OW, M, DM, OW}; pg8::StaticOrder S; S.init(M, DM, (int)gridDim.x, (int)blockIdx.x);
#if OUT_I8
            pg8::EpiResI8<CQ_FP8 != 0> E{BFP(WS_XB), (float*)(ws + WS_SSP), (const float*)(ws + WS_CSC) + l * DM};
            pg8::gemm_phase<pg8::EpiResI8<CQ_FP8 != 0>, pg8::StaticOrder, true, true, 2>(F.lds, g, S, E, F.wave);
#else
            pg8::EpiRes<1, CQ_FP8 != 0> E{BFP(WS_XB), (float*)(ws + WS_SSP)};
            pg8::gemm_phase<pg8::EpiRes<1, CQ_FP8 != 0>, pg8::StaticOrder, true, true>(F.lds, g, S, E, F.wave);
#endif
#else
            NEpiRes E{l == 0 ? args.in[0] : F.X, F.X, BFP(WS_XB), (float*)(ws + WS_SSP)}; ngemm(F, BFP(WS_MRG), BFP(WS_WOUT) + (size_t)l * DM * OW, M, DM, OW, E);
#endif
        }
        SEAM(pb + LP_OUT);
        if (IN(pb + LP_CQ)) {
#if FAST_CQ && CQ_FP8
            pg8::Gemm g{BFP(WS_XB8), BFP(WS_WCQ + (size_t)l * CW * DM), M, CW, DM}; pg8::StaticOrder S; S.init(M, CW, (int)gridDim.x, (int)blockIdx.x);
            pg8::rstd_table(F.lds, ssp, S, F.wave);
            pg8::EpiOut<0> E{(const LAS float*)(F.lds + pg8::RTAB_OFF), BFP(WS_QC), C2 / W8_CQ_SCALE, 0};
            pg8::gemm_phase<pg8::EpiOut<0>, pg8::StaticOrder, true, true, true>(F.lds, g, S, E, F.wave);
#elif FAST_CQ
            pg8::Gemm g{BFP(WS_XB), BFP(WS_WCQ) + (size_t)l * CW * DM, M, CW, DM}; pg8::StaticOrder S; S.init(M, CW, (int)gridDim.x, (int)blockIdx.x);
            pg8::rstd_table(F.lds, ssp, S, F.wave);
            pg8::EpiOut<0> E{(const LAS float*)(F.lds + pg8::RTAB_OFF), BFP(WS_QC), C2, 0};
            pg8::gemm_phase<pg8::EpiOut<0>, pg8::StaticOrder, true, true>(F.lds, g, S, E, F.wave);
#else
            NEpiCq E{ssp, BFP(WS_QC)}; ngemm(F, BFP(WS_XB), BFP(WS_WCQ) + (size_t)l * CW * DM, M, CW, DM, E);
#endif
        }
        SEAM(pb + LP_CQ);
        if (IN(pb + LP_XATT)) { ENTER();
#if FAST_XATT
            fast_xattn(F, l);
#else
            naive_xattn(F, l);
#endif
        }
        SEAM(pb + LP_XATT);
        if (IN(pb + LP_CO)) {
#if FAST_RES && CO_FP8
            pg8::Gemm g{BFP(WS_OCR), BFP(WS_WCO + (size_t)l * DM * CW), M, DM, CW}; pg8::StaticOrder S; S.init(M, DM, (int)gridDim.x, (int)blockIdx.x);
            pg8::EpiRes<32, MLP_FP8 != 0> E{BFP(WS_XB), (float*)(ws + WS_SSP)};
            pg8::gemm_phase<pg8::EpiRes<32, MLP_FP8 != 0>, pg8::StaticOrder, true, true, true>(F.lds, g, S, E, F.wave);
#elif FAST_RES
            pg8::Gemm g{BFP(WS_OCR), BFP(WS_WCO) + (size_t)l * DM * CW, M, DM, CW}; pg8::StaticOrder S; S.init(M, DM, (int)gridDim.x, (int)blockIdx.x);
            pg8::EpiRes<1, MLP_FP8 != 0> E{BFP(WS_XB), (float*)(ws + WS_SSP)};
            pg8::gemm_phase<pg8::EpiRes<1, MLP_FP8 != 0>, pg8::StaticOrder, true, true>(F.lds, g, S, E, F.wave);
#else
            NEpiRes E{F.X, F.X, BFP(WS_XB), (float*)(ws + WS_SSP)}; ngemm(F, BFP(WS_OCR), BFP(WS_WCO) + (size_t)l * DM * CW, M, DM, CW, E);
#endif
        }
        SEAM(pb + LP_CO);
        if (IN(pb + LP_UP)) {
#if FAST_UP && MLP_FP8
            pg8::Gemm g{BFP(WS_XB8), BFP(WS_WUP + (size_t)l * FF * DM), M, FF, DM}; pg8::StaticOrder S; S.init(M, FF, (int)gridDim.x, (int)blockIdx.x);
            pg8::rstd_table(F.lds, ssp, S, F.wave);
            pg8::EpiOut<3> E{(const LAS float*)(F.lds + pg8::RTAB_OFF), BFP(WS_ACT), 1.f / W8_UP_SCALE, 0};
            pg8::gemm_phase<pg8::EpiOut<3>, pg8::StaticOrder, true, true, true>(F.lds, g, S, E, F.wave);
#elif FAST_UP
            pg8::Gemm g{BFP(WS_XB), BFP(WS_WUP) + (size_t)l * FF * DM, M, FF, DM}; pg8::StaticOrder S; S.init(M, FF, (int)gridDim.x, (int)blockIdx.x);
            pg8::rstd_table(F.lds, ssp, S, F.wave);
            pg8::EpiOut<1> E{(const LAS float*)(F.lds + pg8::RTAB_OFF), BFP(WS_ACT), 1.f, 0};
            pg8::gemm_phase<pg8::EpiOut<1>, pg8::StaticOrder, true, true>(F.lds, g, S, E, F.wave);
#else
            NEpiUp E{ssp, BFP(WS_ACT)}; ngemm(F, BFP(WS_XB), BFP(WS_WUP) + (size_t)l * FF * DM, M, FF, DM, E);
#endif
        }
        SEAM(pb + LP_UP);
        if (IN(pb + LP_DN)) {
#if FAST_RES && MLP_FP8
            pg8::Gemm g{BFP(WS_ACT), BFP(WS_WDN + (size_t)l * DM * FF), M, DM, FF}; pg8::StaticOrder S; S.init(M, DM, (int)gridDim.x, (int)blockIdx.x);
            if (l == DEPTH - 1) {
                pg8::EpiRes<128, false> E{BFP(WS_XB), (float*)(ws + WS_SSP)};
                pg8::gemm_phase<pg8::EpiRes<128, false>, pg8::StaticOrder, true, true, true>(F.lds, g, S, E, F.wave);
            } else {
                pg8::EpiRes<128, V_FP8 != 0> E{BFP(WS_XB), (float*)(ws + WS_SSP)};
                pg8::gemm_phase<pg8::EpiRes<128, V_FP8 != 0>, pg8::StaticOrder, true, true, true>(F.lds, g, S, E, F.wave); }
#elif FAST_RES
            pg8::Gemm g{BFP(WS_ACT), BFP(WS_WDN) + (size_t)l * DM * FF, M, DM, FF}; pg8::StaticOrder S; S.init(M, DM, (int)gridDim.x, (int)blockIdx.x);
            pg8::EpiRes<1, false> E{BFP(WS_XB), (float*)(ws + WS_SSP)};
            pg8::gemm_phase<pg8::EpiRes<1, false>, pg8::StaticOrder, true, true>(F.lds, g, S, E, F.wave);
#else
            NEpiRes E{F.X, F.X, BFP(WS_XB), (float*)(ws + WS_SSP)}; ngemm(F, BFP(WS_ACT), BFP(WS_WDN) + (size_t)l * DM * FF, M, DM, FF, E);
#endif
        }
        SEAM(pb + LP_DN);
    }
    if (IN(PH_FINAL)) { ENTER(); phase_final(F, args.in[16]); }
#undef IN
}

extern "C" void kernel_launch(void* const* d_in, const int* in_sizes, int n_in, void* d_out, int out_size, void* d_ws, size_t ws_size, hipStream_t stream) {
    static int grid = 0;
    if (grid == 0) {
        if (n_in != 17 || out_size != M * DM || ws_size < WS_END) { fprintf(stderr, "kernel_launch: unexpected shapes (n_in %d out %d ws %zu)\n", n_in, out_size, ws_size); grid = -1; return; }
        int dev = 0, cus = 0;
        if (hipGetDevice(&dev) != hipSuccess || hipDeviceGetAttribute(&cus, hipDeviceAttributeMultiprocessorCount, dev) != hipSuccess) { grid = -1; return; }
        if (hipFuncSetAttribute((const void*)mk_fwd, hipFuncAttributeMaxDynamicSharedMemorySize, LDS_BYTES) != hipSuccess) { grid = -1; return; }
        if (cus < 256) { fprintf(stderr, "kernel_launch: built for a 256-CU device (one resident workgroup per CU, 8 GEMM units per workgroup at most); found %d CUs, nothing launched\n", cus); grid = -1; return; }
        grid = 256;
    }
    if (grid < 0) return;
    (void)hipMemsetAsync((char*)d_ws + WS_CTL, 0, CTL_ZERO_BYTES, stream);
    Args a{};
    for (int i = 0; i < 17; ++i) a.in[i] = (const float*)d_in[i];
    a.out = (float*)d_out; a.ws = (unsigned char*)d_ws;
#if MK_ONE_LAUNCH
    a.ph_lo = 0; a.ph_hi = NPH; hipLaunchKernelGGL(mk_fwd, dim3(grid), dim3(NTHREADS), LDS_BYTES, stream, a);
#else
    for (int ph = 0; ph < NPH; ++ph) { a.ph_lo = ph; a.ph_hi = ph + 1; hipLaunchKernelGGL(mk_fwd, dim3(grid), dim3(NTHREADS), LDS_BYTES, stream, a); }
#endif
}
```

```cpp
#include <hip/hip_runtime.h>
#include <cstdio>
#include <cstdint>

constexpr int DM = 2048, BATCH = 4, SEQ = 4096, DEPTH = 4, HD = 128, NH = 16;
constexpr int M = BATCH * SEQ;
constexpr int NQKV = 3 * DM, OW = 1536, CW = 512, FF = 8192, MEML = 256, MROWS = BATCH * MEML;
constexpr float EPS = 1e-6f;
#ifndef MLP_FP8
#define MLP_FP8 1
#endif
#ifndef V_FP8
#define V_FP8 1
#endif
constexpr float W8_V_SCALE = 64.f, W8_CQ_SCALE = 64.f;
#ifndef CO_FP8
#define CO_FP8 1
#endif
constexpr float W8_CO_SCALE = 32.f;
#ifndef CQ_FP8
#define CQ_FP8 1
#endif
#ifndef MOBA_GATHER
#define MOBA_GATHER 1
#endif
#ifndef OUT_I8
#define OUT_I8 1
#endif
constexpr float W8_UP_SCALE = 64.f, W8_DN_SCALE = 128.f;
constexpr float C2 = 0.08838834764831845f * 1.4426950408889634f;

constexpr size_t MiB = 1u << 20;
constexpr size_t WS_CTL = 0, CTL_ZERO_BYTES = 64 * 1024;
constexpr size_t WS_WIN = 1 * MiB, WS_WOUT = 97 * MiB, WS_WCQ = 121 * MiB, WS_WCO = 129 * MiB, WS_WUP = 137 * MiB, WS_WDN = 265 * MiB, WS_WCKV = 393 * MiB;
constexpr size_t WS_MEMN = 409 * MiB, WS_CK = 413 * MiB, WS_CV = 417 * MiB, WS_ROPE = 421 * MiB, WS_SSP = 423 * MiB, WS_KMP = 425 * MiB, WS_LSE = 426 * MiB;
constexpr size_t WS_XB = 427 * MiB, WS_MRG = 491 * MiB, WS_QC = 539 * MiB, WS_OCR = 555 * MiB, WS_R1 = 571 * MiB, WS_XB8 = 827 * MiB, WS_WV8 = 859 * MiB, WS_RSC = 875 * MiB, WS_CSC = WS_RSC + 64 * 1024, WS_PART = 876 * MiB, WS_PLSE = 940 * MiB, WS_SEL = 941 * MiB, WS_CNT = WS_SEL + 512 * 1024, WS_LIST = 942 * MiB, WS_END = 944 * MiB;
constexpr size_t WS_Q = WS_R1, WS_K = WS_R1 + 64 * MiB, WS_V = WS_R1 + 128 * MiB, WS_OA = WS_R1 + 192 * MiB, WS_OB = WS_R1 + 208 * MiB, WS_OC = WS_R1 + 232 * MiB, WS_ACT = WS_R1;

constexpr int PH_PRO0 = 0, PH_PRO1 = 1, PH_L0 = 2, PH_PER_LAYER = 10, PH_FINAL = PH_L0 + PH_PER_LAYER * DEPTH, NPH = PH_FINAL + 1;
enum { LP_QKV = 0, LP_KM = 1, LP_ATT = 2, LP_MRG = 3, LP_OUT = 4, LP_CQ = 5, LP_XATT = 6, LP_CO = 7, LP_UP = 8, LP_DN = 9 };

constexpr int NWAVES = 8, NTHREADS = 512;
constexpr int LDS_BYTES = 147456, MISC_OFF = 131072 + 1024;
constexpr int CW_BAR = 4096;

#define GAS __attribute__((address_space(1)))
#define LAS __attribute__((address_space(3)))
typedef unsigned short bf16;
typedef unsigned u32x4 __attribute__((ext_vector_type(4)));
typedef unsigned u32x2 __attribute__((ext_vector_type(2)));
typedef float f32x4 __attribute__((ext_vector_type(4)));
typedef short bf16x8 __attribute__((ext_vector_type(8)));
#define LDS_WAIT() asm volatile("s_waitcnt lgkmcnt(0)" ::: "memory")

__device__ __forceinline__ unsigned f2bf(float f) { unsigned u = __builtin_bit_cast(unsigned, f); return (u + 0x7fffu + ((u >> 16) & 1u)) >> 16; }
__device__ __forceinline__ unsigned pk2(float lo, float hi) { return f2bf(lo) | (f2bf(hi) << 16); }
__device__ __forceinline__ float bflo(unsigned w) { return __builtin_bit_cast(float, w << 16); }
__device__ __forceinline__ float bfhi(unsigned w) { return __builtin_bit_cast(float, w & 0xffff0000u); }
template <int X> __device__ __forceinline__ float xor_lane(float v) { return __builtin_bit_cast(float, __builtin_amdgcn_ds_swizzle(__builtin_bit_cast(int, v), (X << 10) | 0x1F)); }
__device__ __forceinline__ float sum_xor32(float v) { float w = v; asm volatile("" : "+v"(w));   auto rr = __builtin_amdgcn_permlane32_swap(__builtin_bit_cast(unsigned, v), __builtin_bit_cast(unsigned, w), false, false); return __builtin_bit_cast(float, rr[0]) + __builtin_bit_cast(float, rr[1]); }
__device__ __forceinline__ float max_xor32(float v) { float w = v; asm volatile("" : "+v"(w)); auto rr = __builtin_amdgcn_permlane32_swap(__builtin_bit_cast(unsigned, v), __builtin_bit_cast(unsigned, w), false, false); return fmaxf(__builtin_bit_cast(float, rr[0]), __builtin_bit_cast(float, rr[1])); }
__device__ __forceinline__ float get_xor32(float v, int hi) { float w = v; asm volatile("" : "+v"(w)); auto rr = __builtin_amdgcn_permlane32_swap(__builtin_bit_cast(unsigned, v), __builtin_bit_cast(unsigned, w), false, false); return __builtin_bit_cast(float, hi ? rr[0] : rr[1]); }
__device__ __forceinline__ float rdlane(float v, int l) { return __builtin_bit_cast(float, __builtin_amdgcn_readlane(__builtin_bit_cast(int, v), l)); }
__device__ __forceinline__ unsigned pk4i8(float a, float b, float c, float d) {
    const int ia = (int)rintf(a) & 255, ib = (int)rintf(b) & 255, ic = (int)rintf(c) & 255, id = (int)rintf(d) & 255;
    return (unsigned)(ia | (ib << 8) | (ic << 16) | (id << 24)); }
__device__ __forceinline__ float wave_sum(float v) { v += xor_lane<1>(v); v += xor_lane<2>(v); v += xor_lane<4>(v); v += xor_lane<8>(v); v += xor_lane<16>(v); return rdlane(v, 0) + rdlane(v, 32); }
__device__ __forceinline__ float wave_max(float v) { v = fmaxf(v, xor_lane<1>(v)); v = fmaxf(v, xor_lane<2>(v)); v = fmaxf(v, xor_lane<4>(v)); v = fmaxf(v, xor_lane<8>(v)); v = fmaxf(v, xor_lane<16>(v)); return fmaxf(rdlane(v, 0), rdlane(v, 32)); }
__device__ __forceinline__ unsigned pk4f8(float a, float b, float c, float d) { int p = __builtin_amdgcn_cvt_pk_fp8_f32(a, b, 0, false); p = __builtin_amdgcn_cvt_pk_fp8_f32(c, d, p, true); return (unsigned)p; }
__device__ __forceinline__ int lane_id() { int r; asm volatile("v_mbcnt_lo_u32_b32 %0, -1, 0\n\tv_mbcnt_hi_u32_b32 %0, -1, %0" : "=v"(r)); return r; }
__device__ __forceinline__ float ex2(float x) { return __builtin_amdgcn_exp2f(x); }
__device__ __forceinline__ float lg2(float x) { return __builtin_amdgcn_logf(x); }
__device__ __forceinline__ float rstd_from_ssp(const float* ssp, int row, float invn) {
    const f32x4* p = (const f32x4*)(ssp + (size_t)row * 32); float s = 0.f;
#pragma unroll
    for (int i = 0; i < 8; ++i) { const f32x4 v = p[i]; s += (v.x + v.y) + (v.z + v.w); }
    return 1.0f / sqrtf(s * invn + EPS);
}

namespace pg8 {
#define PG8_LAS __attribute__((address_space(3)))
typedef unsigned short bf16_t;
typedef short bf16x8 __attribute__((ext_vector_type(8)));
typedef float f32x4 __attribute__((ext_vector_type(4)));
typedef unsigned u32x4 __attribute__((ext_vector_type(4)));
typedef int v4i_t __attribute__((ext_vector_type(4)));
constexpr int BM = 256, BK = 64, HALF = 128, HTB = HALF * BK * 2  , STAGE_BYTES = 8 * HTB, NXCD = 8, WGM = 8;

__host__ __device__ __forceinline__ int lds_byte(int r, int c) { const int st = (r >> 4) * 2 + (c >> 5), rr = r & 15, cc = c & 31, ob = rr * 64 + cc * 2; return st * 1024 + (ob ^ (((ob >> 9) & 1) << 5)); }
__host__ __device__ __forceinline__ void stage_rc(int b, int& R, int& C) { const int st = b / 1024, sb = b % 1024, swz = sb ^ (((sb >> 9) & 1) << 5); R = (st >> 1) * 16 + swz / 64; C = (st & 1) * 32 + (swz % 64) / 2; }
__host__ __device__ __forceinline__ int perm32(int rho) { const int n = rho >> 4, i = rho & 15; return 8 * (i >> 2) + 4 * n + (i & 3); }

struct Unit { int pm, pn, idx; };
struct Gemm { const bf16_t* A; const bf16_t* Bt; int M, N, K; };

struct StaticOrder {
    int nM, nN, nwg, G, c;
    __host__ __device__ void init(int M, int N, int G_, int c_) { nM = M / BM; nN = N / BM; nwg = nM * nN; G = G_; c = c_; }
    __host__ __device__ bool next(int i, Unit& u) const {
        const long L = (long)i * G + c; if (L >= nwg) return false;
        int wgid = (int)L; { const int q = nwg / NXCD, r = nwg % NXCD, xcd = wgid % NXCD, off = wgid / NXCD; wgid = (xcd < r ? xcd * (q + 1) : r * (q + 1) + (xcd - r) * q) + off; }
        const int nig = WGM * nN, gid = wgid / nig, fm = gid * WGM, gsz = (nM - fm) < WGM ? (nM - fm) : WGM;
        u.pm = fm + ((wgid % nig) % gsz); u.pn = (wgid % nig) / gsz; u.idx = i; return true;
    }
    __device__ __forceinline__ void a_ready(const Unit&) const {}
    __device__ __forceinline__ void done(const Unit&) const {}
};
struct OneUnit { int pm, pn;
    __device__ __forceinline__ bool next(int i, Unit& u) const { if (i) return false; u.pm = pm; u.pn = pn; u.idx = 0; return true; }
    __device__ __forceinline__ void a_ready(const Unit&) const {}
    __device__ __forceinline__ void done(const Unit&) const {}
};

__device__ __forceinline__ unsigned cvt_pk_bf16(float lo, float hi) { unsigned r; asm volatile("v_cvt_pk_bf16_f32 %0, %1, %2" : "=v"(r) : "v"(lo), "v"(hi)); return r; }
template <class Epi, class Sched, bool ALIGN_EPI = false, bool SP2 = false, int F8 = 0>
__device__ __forceinline__ void gemm_phase(PG8_LAS unsigned char* lds, const Gemm g, const Sched& S, const Epi& E, const int wid_in) {
    int wid = wid_in; asm volatile("" : "+s"(wid));
    const int lane_ = lane_id();
    const int lane = lane_, tid = wid * 64 + lane, wr = wid >> 2, wc = wid & 3, fr = lane & 15, fq = lane >> 4;
    const int Kb = F8 ? g.K : 2 * g.K, nt = Kb / (2 * BK);
    unsigned voffA[2], voffB[2];
#pragma unroll
    for (int i = 0; i < 2; ++i) { int R, C; stage_rc(tid * 16 + i * 8192, R, C); const int Rb = Epi::PERM ? ((R & ~31) + perm32(R & 31)) : R;
        voffA[i] = (unsigned)(R * Kb + C * 2); voffB[i] = (unsigned)(Rb * Kb + C * 2); }
    const size_t kstep = (size_t)(BK * 2);
    const size_t hstep = (size_t)HALF * Kb;
    const size_t tstep = 2 * hstep;
    const unsigned ldsb = (unsigned)(size_t)lds + (unsigned)wid * 1024u;
    const unsigned ldsw = (unsigned)wid * 1024u;
    const int aoff = lds_byte(wr * 64 + fr, fq * 8), boff = lds_byte(wc * 32 + fr, fq * 8);
#define PG8_SA(b, h) (((b) * 2 + (h)) * HTB)
#define PG8_SB(b, h) ((4 + (b) * 2 + (h)) * HTB)
#define PG8_STAGE(bufoff, gbase, voff) do { _Pragma("unroll") for (int _i = 0; _i < 2; ++_i) { \
        asm volatile("s_mov_b32 m0, %2\n\ts_nop 0\n\tglobal_load_lds_dwordx4 %0, %1" :: "v"((voff)[_i]), "s"((const char*)(gbase)), "s"(ldsb + (unsigned)((bufoff) + _i * 8192)) : "memory", "m0"); } } while (0)
#define PG8_LDA(dst, b, h) do { _Pragma("unroll") for (int m = 0; m < 4; ++m) _Pragma("unroll") for (int k = 0; k < 2; ++k) dst[m][k] = *(const PG8_LAS bf16x8*)(lds + PG8_SA(b, h) + aoff + m * 2048 + k * 1024); } while (0)
#define PG8_LDB(dst, b, h) do { _Pragma("unroll") for (int n = 0; n < 2; ++n) _Pragma("unroll") for (int k = 0; k < 2; ++k) dst[n][k] = *(const PG8_LAS bf16x8*)(lds + PG8_SB(b, h) + boff + n * 2048 + k * 1024); } while (0)
#define PG8_CAT(x0, x1) __builtin_shufflevector(__builtin_bit_cast(v4i_t, x0), __builtin_bit_cast(v4i_t, x1), 0, 1, 2, 3, 4, 5, 6, 7)
#define PG8_MMA(ai, bj, At, Bt) do { __builtin_amdgcn_s_setprio(1); _Pragma("unroll") for (int m = 0; m < 4; ++m) _Pragma("unroll") for (int n = 0; n < 2; ++n) { \
        if constexpr (F8 == 1) asm volatile("s_nop 1\n\tv_mfma_scale_f32_16x16x128_f8f6f4 %0, %1, %2, %0, %3, %3 op_sel_hi:[0,0,0]" : "+v"(acc[ai][bj][m][n]) : "v"(PG8_CAT(Bt[n][0], Bt[n][1])), "v"(PG8_CAT(At[m][0], At[m][1])), "v"(scale1_));   \
        else if constexpr (F8 == 2) { _Pragma("unroll") for (int k = 0; k < 2; ++k) acc[ai][bj][m][n] = __builtin_bit_cast(f32x4, __builtin_amdgcn_mfma_i32_16x16x64_i8(__builtin_bit_cast(v4i_t, Bt[n][k]), __builtin_bit_cast(v4i_t, At[m][k]), __builtin_bit_cast(v4i_t, acc[ai][bj][m][n]), 0, 0, 0)); } \
        else { _Pragma("unroll") for (int k = 0; k < 2; ++k) acc[ai][bj][m][n] = __builtin_amdgcn_mfma_f32_16x16x32_bf16(Bt[n][k], At[m][k], acc[ai][bj][m][n], 0, 0, 0); } } \
        __builtin_amdgcn_s_setprio(0); } while (0)
#define PG8_WAIT_V(n) asm volatile("s_waitcnt vmcnt(" #n ")" ::: "memory")
#define PG8_WAIT_L(n) asm volatile("s_waitcnt lgkmcnt(" #n ")" ::: "memory")
#define PG8_BAR __builtin_amdgcn_s_barrier()
#define PG8_SCHED __builtin_amdgcn_sched_barrier(0)
    Unit cur, nxt; int ui = 0;
    if (!S.next(0, cur)) return;
    f32x4 acc[2][2][4][2];
    int scale1_ = 0x7f7f7f7f; asm volatile("" : "+v"(scale1_));
    float zero_ = 0.f; asm volatile("" : "+v"(zero_));
#pragma unroll
    for (int a = 0; a < 2; ++a)
#pragma unroll
        for (int b = 0; b < 2; ++b)
#pragma unroll
            for (int m = 0; m < 4; ++m)
#pragma unroll
                for (int n = 0; n < 2; ++n) acc[a][b][m][n] = (f32x4){zero_, zero_, zero_, zero_};
    bf16x8 At[4][2], B0[2][2], B1[2][2];
    const char* cA = (const char*)g.A + (size_t)cur.pm * tstep; const char* cB = (const char*)g.Bt + (size_t)cur.pn * tstep;
    S.a_ready(cur);
    if constexpr (SP2) {
        PG8_STAGE(PG8_SB(0, 0), cB, voffB); PG8_STAGE(PG8_SB(0, 1), cB + hstep, voffB); PG8_STAGE(PG8_SA(0, 0), cA, voffA); PG8_STAGE(PG8_SA(0, 1), cA + hstep, voffA);
        if (wr == 1) PG8_BAR;
        PG8_WAIT_V(2); PG8_BAR;
        PG8_STAGE(PG8_SB(1, 0), cB + kstep, voffB); PG8_STAGE(PG8_SA(1, 0), cA + kstep, voffA); PG8_STAGE(PG8_SB(1, 1), cB + hstep + kstep, voffB);
        PG8_WAIT_V(6); PG8_BAR;
    } else {
        PG8_STAGE(PG8_SB(0, 0), cB, voffB); PG8_STAGE(PG8_SA(0, 0), cA, voffA); PG8_STAGE(PG8_SB(0, 1), cB + hstep, voffB); PG8_STAGE(PG8_SA(0, 1), cA + hstep, voffA);
        if (wr == 1) PG8_BAR;
        PG8_WAIT_V(4); PG8_BAR;
        PG8_STAGE(PG8_SB(1, 0), cB + kstep, voffB); PG8_STAGE(PG8_SA(1, 0), cA + kstep, voffA); PG8_STAGE(PG8_SB(1, 1), cB + hstep + kstep, voffB);
        PG8_WAIT_V(6); PG8_BAR;
    }
    for (;;) {
        const bool has_next = S.next(ui + 1, nxt);
        const char* nA = has_next ? (const char*)g.A + (size_t)nxt.pm * tstep : cA; const char* nB = has_next ? (const char*)g.Bt + (size_t)nxt.pn * tstep : cB;
        for (int t = 0; t < nt; t += 2) {
            const bool last = (t == nt - 2);
            const char* a1 = cA + (size_t)(t + 1) * kstep;
            const char* a2 = last ? nA : cA + (size_t)(t + 2) * kstep; const char* b2 = last ? nB : cB + (size_t)(t + 2) * kstep;
            const char* a3 = a2 + kstep; const char* b3 = b2 + kstep;
            if (last && has_next) S.a_ready(nxt);
            if constexpr (SP2) {
            PG8_LDB(B0, 0, 0); PG8_LDB(B1, 0, 1); PG8_SCHED; PG8_LDA(At, 0, 0); PG8_STAGE(PG8_SA(1, 1), a1 + hstep, voffA);
            PG8_WAIT_V(8); PG8_WAIT_L(0); PG8_BAR; PG8_MMA(0, 0, At, B0); PG8_MMA(0, 1, At, B1); PG8_BAR; PG8_SCHED;
            PG8_LDA(At, 0, 1); PG8_STAGE(PG8_SB(0, 0), b2, voffB); PG8_STAGE(PG8_SB(0, 1), b2 + hstep, voffB); PG8_STAGE(PG8_SA(0, 0), a2, voffA);
            PG8_WAIT_V(8); PG8_WAIT_L(0); PG8_BAR; PG8_MMA(1, 0, At, B0); PG8_MMA(1, 1, At, B1); PG8_BAR; PG8_SCHED;
            PG8_LDB(B0, 1, 0); PG8_LDB(B1, 1, 1); PG8_SCHED; PG8_LDA(At, 1, 0); PG8_STAGE(PG8_SA(0, 1), a2 + hstep, voffA);
            PG8_WAIT_V(8); PG8_WAIT_L(0); PG8_BAR; PG8_MMA(0, 0, At, B0); PG8_MMA(0, 1, At, B1); PG8_BAR; PG8_SCHED;
            PG8_LDA(At, 1, 1); PG8_STAGE(PG8_SB(1, 0), b3, voffB); PG8_STAGE(PG8_SB(1, 1), b3 + hstep, voffB); PG8_STAGE(PG8_SA(1, 0), a3, voffA);
            PG8_WAIT_V(8); PG8_WAIT_L(0); PG8_BAR; PG8_MMA(1, 0, At, B0); PG8_MMA(1, 1, At, B1); PG8_BAR; PG8_SCHED;
            } else {
            PG8_LDB(B0, 0, 0); PG8_SCHED; PG8_LDA(At, 0, 0); PG8_STAGE(PG8_SA(1, 1), a1 + hstep, voffA);
            PG8_WAIT_L(8); PG8_BAR; PG8_WAIT_L(0); PG8_MMA(0, 0, At, B0); PG8_BAR; PG8_SCHED;
            PG8_LDB(B1, 0, 1); PG8_STAGE(PG8_SB(0, 0), b2, voffB);
            PG8_BAR; PG8_WAIT_L(0); PG8_MMA(0, 1, At, B1); PG8_BAR;
            PG8_LDA(At, 0, 1); PG8_STAGE(PG8_SA(0, 0), a2, voffA);
            PG8_BAR; PG8_WAIT_L(0); PG8_MMA(1, 0, At, B0); PG8_BAR; PG8_SCHED;
            PG8_STAGE(PG8_SB(0, 1), b2 + hstep, voffB);
            PG8_WAIT_V(6); PG8_BAR; PG8_MMA(1, 1, At, B1); PG8_BAR;
            PG8_LDB(B0, 1, 0); PG8_SCHED; PG8_LDA(At, 1, 0); PG8_STAGE(PG8_SA(0, 1), a2 + hstep, voffA);
            PG8_WAIT_L(8); PG8_BAR; PG8_WAIT_L(0); PG8_MMA(0, 0, At, B0); PG8_BAR; PG8_SCHED;
            PG8_LDB(B1, 1, 1); PG8_STAGE(PG8_SB(1, 0), b3, voffB);
            PG8_BAR; PG8_WAIT_L(0); PG8_MMA(0, 1, At, B1); PG8_BAR;
            PG8_LDA(At, 1, 1); PG8_STAGE(PG8_SA(1, 0), a3, voffA);
            PG8_BAR; PG8_WAIT_L(0); PG8_MMA(1, 0, At, B0); PG8_BAR; PG8_SCHED;
            PG8_STAGE(PG8_SB(1, 1), b3 + hstep, voffB);
            PG8_WAIT_V(6); PG8_BAR; PG8_MMA(1, 1, At, B1); PG8_BAR;
            }
        }
        if constexpr (ALIGN_EPI) { if (wr == 0) PG8_BAR; }
        if constexpr (F8 == 1) asm volatile("s_nop 15\n\ts_nop 15" ::: "memory");
        if constexpr (!Epi::AFTER_DRAIN) { E(acc, cur, wr, wc, fr, fq); S.done(cur); }
        if (!has_next) break;
#pragma unroll
        for (int a = 0; a < 2; ++a)
#pragma unroll
            for (int b = 0; b < 2; ++b)
#pragma unroll
                for (int m = 0; m < 4; ++m)
#pragma unroll
                    for (int n = 0; n < 2; ++n) acc[a][b][m][n] = (f32x4){zero_, zero_, zero_, zero_};
        cur = nxt; cA = nA; cB = nB; ++ui;
        if constexpr (ALIGN_EPI) { if (wr == 1) PG8_BAR; }
    }
    PG8_WAIT_V(0);
    if constexpr (!ALIGN_EPI) { if (wr == 0) PG8_BAR; }
    PG8_BAR;
    if constexpr (Epi::AFTER_DRAIN) { E.fused(acc, cur, wr, wc, fr, fq, lds, wid, lane); S.done(cur); }
#undef PG8_SA
#undef PG8_SB
#undef PG8_STAGE
#undef PG8_LDA
#undef PG8_LDB
#undef PG8_MMA
#undef PG8_CAT
#undef PG8_WAIT_V
#undef PG8_WAIT_L
#undef PG8_BAR
#undef PG8_SCHED
}
}

constexpr size_t XB8_DELTA = WS_XB8 - WS_XB;
namespace pg8 {
typedef unsigned u32x2e __attribute__((ext_vector_type(2)));
__device__ __forceinline__ u32x4 pack8(const f32x4 a, const f32x4 b) { u32x4 w; w.x = cvt_pk_bf16(a[0], a[1]); w.y = cvt_pk_bf16(a[2], a[3]); w.z = cvt_pk_bf16(b[0], b[1]); w.w = cvt_pk_bf16(b[2], b[3]); return w; }
constexpr int RTAB_OFF = 133120, RTAB_UNITS = 8;
template <class Sched>
__device__ __forceinline__ void rstd_table(PG8_LAS unsigned char* lds, const float* ssp, const Sched& S, int wid) {
    const int t = wid * 64 + lane_id(); PG8_LAS float* tab = (PG8_LAS float*)(lds + RTAB_OFF);
    Unit u;
#pragma unroll 1
    for (int i = 0; i < RTAB_UNITS && S.next(i, u); ++i) { const f32x4* p = (const f32x4*)(ssp + (size_t)(u.pm * BM + (t >> 1)) * 32 + (t & 1) * 16); float s = 0.f;
#pragma unroll
        for (int j = 0; j < 4; ++j) { const f32x4 a = p[j]; s += (a[0] + a[1]) + (a[2] + a[3]); }
        s += xor_lane<1>(s);
        if ((t & 1) == 0) tab[i * 256 + (t >> 1)] = 1.0f / sqrtf(s * (1.0f / 2048.0f) + 1e-6f); }
    __syncthreads();
}
__device__ __forceinline__ void rstd8(const PG8_LAS float* tab, const Unit& u, int wr, int fr, float (&rs)[2][4]) {
#pragma unroll
    for (int ai = 0; ai < 2; ++ai)
#pragma unroll
        for (int m = 0; m < 4; ++m) rs[ai][m] = tab[u.idx * 256 + ai * HALF + wr * 64 + m * 16 + fr];
}
struct EpiQKV {
    static constexpr bool PERM = true, AFTER_DRAIN = false;
    const PG8_LAS float* rtab; const float* cosT; const float* sinT; bf16_t* Q; size_t tstride; float* KMP; float qscale; int tbase; float vsc;
    __device__ __forceinline__ void operator()(const f32x4 (&acc)[2][2][4][2], const Unit& u, int wr, int wc, int, int) const {
        const int t_ = lane_id(), fr = t_ & 15, fq = t_ >> 4;
        const int row0 = u.pm * BM + wr * 64 + fr, t = tbase + (u.pn >> 3), hp = (u.pn & 7) * 2, b = u.pm >> 4, p0 = wc * 32 + 8 * fq;
        float rs[2][4]; rstd8(rtab, u, wr, fr, rs);
        const bool rope = t < 2 && (hp < 4 || hp >= 10);
        const float sc = t == 0 ? qscale : (t == 2 ? vsc : 1.f);
        bf16_t* base = Q + (size_t)t * tstride;
        f32x4 cs[2][2] = {{(f32x4){0.f, 0.f, 0.f, 0.f}, (f32x4){0.f, 0.f, 0.f, 0.f}}, {(f32x4){0.f, 0.f, 0.f, 0.f}, (f32x4){0.f, 0.f, 0.f, 0.f}}};
        const bool kmean = t == 1 && hp < 4;
#pragma unroll
        for (int ai = 0; ai < 2; ++ai)
#pragma unroll
            for (int m = 0; m < 4; ++m) { const int s = (row0 + ai * HALF + m * 16) & 4095; const float r = rs[ai][m] * sc;
                if (rope) { const f32x4 c = *(const f32x4*)(cosT + s * 64 + (p0 >> 1)), sn = *(const f32x4*)(sinT + s * 64 + (p0 >> 1));
#pragma unroll
                    for (int bj = 0; bj < 2; ++bj) { const f32x4 x1 = acc[ai][bj][m][0] * r, x2 = acc[ai][bj][m][1] * r; const f32x4 o1 = x1 * c - x2 * sn, o2 = x2 * c + x1 * sn;
                        if (kmean) { cs[bj][0] += o1; cs[bj][1] += o2; }
                        *(u32x4*)(base + (((size_t)(b * 16 + hp + bj) * 4096 + s) * 128 + p0)) = pack8(o1, o2); } }
                else {
#pragma unroll
                    for (int bj = 0; bj < 2; ++bj) *(u32x4*)(base + (((size_t)(b * 16 + hp + bj) * 4096 + s) * 128 + p0)) = pack8(acc[ai][bj][m][0] * r, acc[ai][bj][m][1] * r); }
                if (m & 1) asm volatile("" ::: "memory"); }
        if (kmean) {
#pragma unroll
            for (int bj = 0; bj < 2; ++bj)
#pragma unroll
                for (int n = 0; n < 2; ++n)
#pragma unroll
                    for (int i = 0; i < 4; ++i) { float v = cs[bj][n][i]; v += xor_lane<1>(v); v += xor_lane<2>(v); v += xor_lane<4>(v); v += xor_lane<8>(v); cs[bj][n][i] = v; }
            if (fr == 0) {
#pragma unroll
                for (int bj = 0; bj < 2; ++bj) { float* kp = KMP + ((size_t)(((b * 4 + hp + bj) * 16 + (u.pm & 15)) * 2 + wr)) * 128 + p0; *(f32x4*)kp = cs[bj][0]; *(f32x4*)(kp + 4) = cs[bj][1]; } }
        }
    }
};
template <int INV_SCALE, bool W8> struct EpiRes {
    static constexpr bool PERM = true, AFTER_DRAIN = false; static constexpr float scale = 1.0f / INV_SCALE;
    bf16_t* XB; float* ssp;
    __device__ __forceinline__ void operator()(const f32x4 (&acc)[2][2][4][2], const Unit& u, int wr, int wc, int, int) const {
        const int t_ = lane_id(), fr = t_ & 15, fq = t_ >> 4;
        const int row0 = u.pm * BM + wr * 64 + fr, col0 = u.pn * BM + wc * 32 + 8 * fq;
#pragma unroll
        for (int ai = 0; ai < 2; ++ai)
#pragma unroll
            for (int m = 0; m < 4; ++m) { const int row = row0 + ai * HALF + m * 16; const size_t off = (size_t)row * 2048 + col0; float ss = 0.f;
#pragma unroll
                for (int bj = 0; bj < 2; ++bj) { const u32x4 w = *(const u32x4*)(XB + off + bj * HALF);
                    f32x4 a = (f32x4){__builtin_bit_cast(float, w.x << 16), __builtin_bit_cast(float, w.x & 0xffff0000u), __builtin_bit_cast(float, w.y << 16), __builtin_bit_cast(float, w.y & 0xffff0000u)};
                    f32x4 c = (f32x4){__builtin_bit_cast(float, w.z << 16), __builtin_bit_cast(float, w.z & 0xffff0000u), __builtin_bit_cast(float, w.w << 16), __builtin_bit_cast(float, w.w & 0xffff0000u)};
                    a = a + acc[ai][bj][m][0] * scale; c = c + acc[ai][bj][m][1] * scale;
                    *(u32x4*)(XB + off + bj * HALF) = pack8(a, c);
                    if (W8) { u32x2e w8; w8.x = pk4f8(a[0], a[1], a[2], a[3]); w8.y = pk4f8(c[0], c[1], c[2], c[3]); *(u32x2e*)((unsigned char*)XB + XB8_DELTA + off + bj * HALF) = w8; }
                    ss += ((a[0] * a[0] + a[1] * a[1]) + (a[2] * a[2] + a[3] * a[3])) + ((c[0] * c[0] + c[1] * c[1]) + (c[2] * c[2] + c[3] * c[3])); }
                ss += xor_lane<16>(ss); ss += __builtin_bit_cast(float, __builtin_amdgcn_ds_bpermute((t_ ^ 32) << 2, __builtin_bit_cast(int, ss)));
                if (fq == 0) ssp[(size_t)row * 32 + u.pn * 4 + wc] = ss;
                if (m & 1) asm volatile("" ::: "memory"); }
    }
};
constexpr size_t RSC_DELTA = WS_RSC - WS_XB;
template <bool W8> struct EpiResI8 {
    static constexpr bool PERM = true, AFTER_DRAIN = false;
    bf16_t* XB; float* ssp; const float* csc;
    __device__ __forceinline__ void operator()(const f32x4 (&acc)[2][2][4][2], const Unit& u, int wr, int wc, int, int) const {
        const int t_ = lane_id(), fr = t_ & 15, fq = t_ >> 4;
        const int row0 = u.pm * BM + wr * 64 + fr, col0 = u.pn * BM + wc * 32 + 8 * fq;
        const float* rsc = (const float*)((const unsigned char*)XB + RSC_DELTA);
        f32x4 cs[2][2];
#pragma unroll
        for (int bj = 0; bj < 2; ++bj) { cs[bj][0] = *(const f32x4*)(csc + col0 + bj * HALF); cs[bj][1] = *(const f32x4*)(csc + col0 + bj * HALF + 4); }
#pragma unroll
        for (int ai = 0; ai < 2; ++ai)
#pragma unroll
            for (int m = 0; m < 4; ++m) { const int row = row0 + ai * HALF + m * 16; const size_t off = (size_t)row * 2048 + col0; float ss = 0.f; const float rsv = rsc[row];
#pragma unroll
                for (int bj = 0; bj < 2; ++bj) { const u32x4 w = *(const u32x4*)(XB + off + bj * HALF);
                    f32x4 a = (f32x4){__builtin_bit_cast(float, w.x << 16), __builtin_bit_cast(float, w.x & 0xffff0000u), __builtin_bit_cast(float, w.y << 16), __builtin_bit_cast(float, w.y & 0xffff0000u)};
                    f32x4 c = (f32x4){__builtin_bit_cast(float, w.z << 16), __builtin_bit_cast(float, w.z & 0xffff0000u), __builtin_bit_cast(float, w.w << 16), __builtin_bit_cast(float, w.w & 0xffff0000u)};
                    const v4i_t i0 = __builtin_bit_cast(v4i_t, acc[ai][bj][m][0]), i1 = __builtin_bit_cast(v4i_t, acc[ai][bj][m][1]);
#pragma unroll
                    for (int i = 0; i < 4; ++i) { a[i] += (float)i0[i] * (rsv * cs[bj][0][i]); c[i] += (float)i1[i] * (rsv * cs[bj][1][i]); }
                    *(u32x4*)(XB + off + bj * HALF) = pack8(a, c);
                    if (W8) { u32x2e w8; w8.x = pk4f8(a[0], a[1], a[2], a[3]); w8.y = pk4f8(c[0], c[1], c[2], c[3]); *(u32x2e*)((unsigned char*)XB + XB8_DELTA + off + bj * HALF) = w8; }
                    ss += ((a[0] * a[0] + a[1] * a[1]) + (a[2] * a[2] + a[3] * a[3])) + ((c[0] * c[0] + c[1] * c[1]) + (c[2] * c[2] + c[3] * c[3])); }
                ss += xor_lane<16>(ss); ss += __builtin_bit_cast(float, __builtin_amdgcn_ds_bpermute((t_ ^ 32) << 2, __builtin_bit_cast(int, ss)));
                if (fq == 0) ssp[(size_t)row * 32 + u.pn * 4 + wc] = ss;
                if (m & 1) asm volatile("" ::: "memory"); }
    }
};
template <int MODE> struct EpiOut {
    static constexpr bool PERM = true, AFTER_DRAIN = false;
    const PG8_LAS float* rtab; bf16_t* O; float scale; size_t tstride;
    __device__ __forceinline__ void operator()(const f32x4 (&acc)[2][2][4][2], const Unit& u, int wr, int wc, int, int) const {
        const int t_ = lane_id(), fr = t_ & 15, fq = t_ >> 4;
        const int row0 = u.pm * BM + wr * 64 + fr, p0 = wc * 32 + 8 * fq;
        float rs[2][4];
        if (MODE != 2) rstd8(rtab, u, wr, fr, rs);
#pragma unroll
        for (int ai = 0; ai < 2; ++ai)
#pragma unroll
            for (int m = 0; m < 4; ++m) { const int row = row0 + ai * HALF + m * 16;
#pragma unroll
                for (int bj = 0; bj < 2; ++bj) { f32x4 a = acc[ai][bj][m][0], c = acc[ai][bj][m][1]; bf16_t* dst;
                    if (MODE == 0) { const float r = rs[ai][m] * scale; a = a * r; c = c * r; dst = O + (((size_t)((row >> 12) * 4 + u.pn * 2 + bj) * 4096 + (row & 4095)) * 128 + p0); }
                    else if (MODE == 1) { const float r = rs[ai][m]; a = a * r; c = c * r;
#pragma unroll
                        for (int i = 0; i < 4; ++i) { a[i] = fmaxf(a[i], 0.f); a[i] *= a[i]; c[i] = fmaxf(c[i], 0.f); c[i] *= c[i]; }
                        dst = O + (size_t)row * 8192 + u.pn * BM + bj * HALF + p0; }
                    else if (MODE == 3) { const float r = rs[ai][m] * scale; a = a * r; c = c * r;
#pragma unroll
                        for (int i = 0; i < 4; ++i) { a[i] = fmaxf(a[i], 0.f); a[i] *= a[i]; c[i] = fmaxf(c[i], 0.f); c[i] *= c[i]; }
                        u32x2e w8; w8.x = pk4f8(a[0], a[1], a[2], a[3]); w8.y = pk4f8(c[0], c[1], c[2], c[3]);
                        *(u32x2e*)((unsigned char*)O + (size_t)row * 8192 + u.pn * BM + bj * HALF + p0) = w8; continue; }
                    else { const int l = u.pn >> 2, t = (u.pn >> 1) & 1, h = (u.pn & 1) * 2 + bj; dst = O + (size_t)t * tstride + ((((size_t)(l * 4 + u.pm) * 4 + h) * 256 + (row & 255)) * 128 + p0); }
                    *(u32x4*)dst = pack8(a, c); }
                if (m & 1) asm volatile("" ::: "memory"); }
    }
};
}

struct Args { const float* in[17]; float* out; unsigned char* ws; int ph_lo, ph_hi; };
struct Frame {
    LAS unsigned char* lds;
    int lane, wave, gw, ngw;
    float* X; unsigned char* ws;
};

template <class RowMap, class Gain>
__device__ __forceinline__ void transpose_item(const float* W, int K, int N, bf16* WT, const RowMap& rm, const Gain& gn, LAS float* scr, int item, int lane) {
    const int nblk = N / 32, kb = item / nblk, nb = item % nblk, k0 = 64 * kb, n0 = 32 * nb;
#pragma unroll 8
    for (int i = 0; i < 32; ++i) { const int kk = 2 * i + (lane >> 5); scr[kk * 33 + (lane & 31)] = __builtin_nontemporal_load(&W[(size_t)(k0 + kk) * N + n0 + (lane & 31)]) * gn(k0 + kk); }
    LDS_WAIT(); asm volatile("" ::: "memory");
    const int c = lane & 7;
#pragma unroll
    for (int j = 0; j < 4; ++j) { const int n = (lane >> 3) + 8 * j; const LAS float* s = scr + (8 * c) * 33 + n;
        u32x4 o; o.x = pk2(s[0 * 33], s[1 * 33]); o.y = pk2(s[2 * 33], s[3 * 33]); o.z = pk2(s[4 * 33], s[5 * 33]); o.w = pk2(s[6 * 33], s[7 * 33]);
        *(u32x4*)(WT + (size_t)rm(n0 + n) * K + k0 + 8 * c) = o; }
    LDS_WAIT(); asm volatile("" ::: "memory");
}
template <class Gain>
__device__ __forceinline__ void transpose_item8(const float* W, int K, int N, unsigned char* WT, const Gain& gn, LAS float* scr, int item, int lane) {
    const int nblk = N / 32, kb = item / nblk, nb = item % nblk, k0 = 64 * kb, n0 = 32 * nb;
#pragma unroll 8
    for (int i = 0; i < 32; ++i) { const int kk = 2 * i + (lane >> 5); scr[kk * 33 + (lane & 31)] = __builtin_nontemporal_load(&W[(size_t)(k0 + kk) * N + n0 + (lane & 31)]) * gn(k0 + kk); }
    LDS_WAIT(); asm volatile("" ::: "memory");
    const int c = lane & 7;
#pragma unroll
    for (int j = 0; j < 4; ++j) { const int n = (lane >> 3) + 8 * j; const LAS float* s = scr + (8 * c) * 33 + n;
        u32x2 o; o.x = pk4f8(s[0 * 33], s[1 * 33], s[2 * 33], s[3 * 33]); o.y = pk4f8(s[4 * 33], s[5 * 33], s[6 * 33], s[7 * 33]);
        *(u32x2*)(WT + (size_t)(n0 + n) * K + k0 + 8 * c) = o; }
    LDS_WAIT(); asm volatile("" ::: "memory");
}
struct GnVecS { const float* g; float s; __device__ __forceinline__ float operator()(int k) const { return g[k] * s; } };
struct GnConst { float s; __device__ __forceinline__ float operator()(int) const { return s; } };
struct RmId { int off; __device__ __forceinline__ int operator()(int n) const { return off + n; } };
struct RmQkv { __device__ __forceinline__ int operator()(int n) const {
    const int t = n >> 11, head = (n >> 7) & 15, d = n & 127; const bool rope = t < 2 && (head < 4 || head >= 10);
    const int p = rope ? (8 * ((d & 63) >> 2) + 4 * (d >> 6) + (d & 3)) : d; return (n & ~127) + p; } };
struct GnOne { __device__ __forceinline__ float operator()(int) const { return 1.f; } };
struct GnVec { const float* g; __device__ __forceinline__ float operator()(int k) const { return g[k]; } };
struct GnOut { const float *ga, *gb, *gc; __device__ __forceinline__ float operator()(int k) const { return k < 512 ? ga[k] : (k < 1280 ? gb[k - 512] : gc[k - 1280]); } };

__device__ __forceinline__ void phase_pro0(Frame& F, const Args& A) {
    LAS float* scr = (LAS float*)(F.lds + F.wave * 16384);
    const float *g_mix = A.in[2], *w_in = A.in[3], *g_oa = A.in[4], *g_ob = A.in[5], *g_oc = A.in[6], *w_out = A.in[7], *g_cross = A.in[8], *g_mem = A.in[9];
    const float *w_cq = A.in[10], *w_ckv = A.in[11], *w_co = A.in[12], *g_mlp = A.in[13], *w_up = A.in[14], *w_down = A.in[15];
    constexpr int I_IN = (DM / 64) * (NQKV / 32), I_OUT = OUT_I8 ? 0 : (OW / 64) * (DM / 32), I_CQ = (DM / 64) * (CW / 32), I_CO = (CW / 64) * (DM / 32), I_UP = (DM / 64) * (FF / 32), I_DN = (FF / 64) * (DM / 32), I_CKV = (DM / 64) * (2 * CW / 32);
    constexpr int I_LAYER = I_IN + I_OUT + I_CQ + I_CO + I_UP + I_DN + I_CKV;
#if OUT_I8
    for (int strip = F.gw >> 3; strip < DEPTH * (DM / 32); strip += F.ngw >> 3) { const int l = strip / (DM / 32), n0 = 32 * (strip % (DM / 32));
        const float* W = w_out + (size_t)l * OW * DM; const GnOut gn{g_oa + l * 512, g_ob + l * 768, g_oc + l * 256};
        float mx = 0.f;
#pragma unroll 1
        for (int t = 0; t < 3; ++t) { const int k0 = 64 * (F.wave * 3 + t);
#pragma unroll 8
            for (int i = 0; i < 32; ++i) { const int kk = 2 * i + (F.lane >> 5); mx = fmaxf(mx, fabsf(W[(size_t)(k0 + kk) * DM + n0 + (F.lane & 31)] * gn(k0 + kk))); } }
        mx = fmaxf(mx, __builtin_bit_cast(float, __builtin_amdgcn_ds_bpermute((F.lane ^ 32) << 2, __builtin_bit_cast(int, mx))));
        LAS float* cmx = (LAS float*)(F.lds + 12288);
        if (F.lane < 32) cmx[F.wave * 32 + F.lane] = mx;
        __syncthreads();
        float cm = 0.f;
#pragma unroll
        for (int w = 0; w < 8; ++w) cm = fmaxf(cm, cmx[w * 32 + (F.lane & 31)]);
        const float inv = cm > 0.f ? 127.f / cm : 0.f;
        if (F.wave == 0 && F.lane < 32) ((float*)(F.ws + WS_CSC))[l * DM + n0 + F.lane] = cm * (1.f / 127.f);
        unsigned char* WT = F.ws + WS_WOUT + (size_t)l * DM * OW;
#pragma unroll 1
        for (int t = 0; t < 3; ++t) { const int k0 = 64 * (F.wave * 3 + t);
#pragma unroll 8
            for (int i = 0; i < 32; ++i) { const int kk = 2 * i + (F.lane >> 5); scr[kk * 33 + (F.lane & 31)] = rintf(W[(size_t)(k0 + kk) * DM + n0 + (F.lane & 31)] * gn(k0 + kk) * inv); }
            LDS_WAIT(); asm volatile("" ::: "memory");
            const int c = F.lane & 7;
#pragma unroll
            for (int j = 0; j < 4; ++j) { const int n = (F.lane >> 3) + 8 * j; const LAS float* sp = scr + (8 * c) * 33 + n; int q[8];
#pragma unroll
                for (int e = 0; e < 8; ++e) q[e] = (int)sp[e * 33] & 255;
                u32x2 o; o.x = (unsigned)(q[0] | (q[1] << 8) | (q[2] << 16) | (q[3] << 24)); o.y = (unsigned)(q[4] | (q[5] << 8) | (q[6] << 16) | (q[7] << 24));
                *(u32x2*)(WT + (size_t)(n0 + n) * OW + k0 + 8 * c) = o; }
            LDS_WAIT(); asm volatile("" ::: "memory"); }
        __syncthreads();
    }
#endif
    for (int it = F.gw; it < I_LAYER * DEPTH; it += F.ngw) {
        const int l = it / I_LAYER; int r = it % I_LAYER;
        if (r < I_IN) {
            if (V_FP8 && (r % (NQKV / 32)) >= 2 * DM / 32) transpose_item8(w_in + (size_t)l * DM * NQKV, DM, NQKV, F.ws + WS_WV8 + (size_t)l * DM * DM - (size_t)2 * DM * DM, GnVecS{g_mix + l * DM, W8_V_SCALE}, scr, r, F.lane);
            else transpose_item(w_in + (size_t)l * DM * NQKV, DM, NQKV, (bf16*)(F.ws + WS_WIN) + (size_t)l * NQKV * DM, RmQkv{}, GnVec{g_mix + l * DM}, scr, r, F.lane);
            continue; } r -= I_IN;
        if (r < I_OUT) { transpose_item(w_out + (size_t)l * OW * DM, OW, DM, (bf16*)(F.ws + WS_WOUT) + (size_t)l * DM * OW, RmId{0}, GnOut{g_oa + l * 512, g_ob + l * 768, g_oc + l * 256}, scr, r, F.lane); continue; } r -= I_OUT;
        if (r < I_CQ) {
            if (CQ_FP8) transpose_item8(w_cq + (size_t)l * DM * CW, DM, CW, F.ws + WS_WCQ + (size_t)l * CW * DM, GnVecS{g_cross + l * DM, W8_CQ_SCALE}, scr, r, F.lane);
            else transpose_item(w_cq + (size_t)l * DM * CW, DM, CW, (bf16*)(F.ws + WS_WCQ) + (size_t)l * CW * DM, RmId{0}, GnVec{g_cross + l * DM}, scr, r, F.lane);
            continue; } r -= I_CQ;
        if (r < I_CO) {
            if (CO_FP8) transpose_item8(w_co + (size_t)l * CW * DM, CW, DM, F.ws + WS_WCO + (size_t)l * DM * CW, GnConst{W8_CO_SCALE}, scr, r, F.lane);
            else transpose_item(w_co + (size_t)l * CW * DM, CW, DM, (bf16*)(F.ws + WS_WCO) + (size_t)l * DM * CW, RmId{0}, GnOne{}, scr, r, F.lane);
            continue; } r -= I_CO;
        #if MLP_FP8
        if (r < I_UP) { transpose_item8(w_up + (size_t)l * DM * FF, DM, FF, F.ws + WS_WUP + (size_t)l * FF * DM, GnVecS{g_mlp + l * DM, W8_UP_SCALE}, scr, r, F.lane); continue; } r -= I_UP;
        if (r < I_DN) { transpose_item8(w_down + (size_t)l * FF * DM, FF, DM, F.ws + WS_WDN + (size_t)l * DM * FF, GnConst{W8_DN_SCALE}, scr, r, F.lane); continue; } r -= I_DN;
#else
        if (r < I_UP) { transpose_item(w_up + (size_t)l * DM * FF, DM, FF, (bf16*)(F.ws + WS_WUP) + (size_t)l * FF * DM, RmId{0}, GnVec{g_mlp + l * DM}, scr, r, F.lane); continue; } r -= I_UP;
        if (r < I_DN) { transpose_item(w_down + (size_t)l * FF * DM, FF, DM, (bf16*)(F.ws + WS_WDN) + (size_t)l * DM * FF, RmId{0}, GnOne{}, scr, r, F.lane); continue; } r -= I_DN;
#endif
        transpose_item(w_ckv + (size_t)l * DM * 2 * CW, DM, 2 * CW, (bf16*)(F.ws + WS_WCKV), RmId{l * 2 * CW}, GnOne{}, scr, r, F.lane);
    }
    { float* cosT = (float*)(F.ws + WS_ROPE); float* sinT = cosT + SEQ * 64;
      for (int i = F.gw * 64 + F.lane; i < SEQ * 64; i += F.ngw * 64) { const int pos = i >> 6, f = i & 63;
          const float inv = 1.0f / powf(10000.0f, (float)(2 * f) / 128.0f); const float ang = (float)pos * inv; cosT[i] = cosf(ang); sinT[i] = sinf(ang); } }
    { const float* mem = A.in[1]; bf16* MN = (bf16*)(F.ws + WS_MEMN);
      for (int row = F.gw; row < MROWS; row += F.ngw) { const f32x4* xr = (const f32x4*)(mem + (size_t)row * DM) + F.lane; f32x4 v[8]; float s = 0.f;
#pragma unroll
          for (int j = 0; j < 8; ++j) { v[j] = xr[64 * j]; s += (v[j].x * v[j].x + v[j].y * v[j].y) + (v[j].z * v[j].z + v[j].w * v[j].w); }
          const float rs = 1.0f / sqrtf(wave_sum(s) * (1.f / DM) + EPS);
#pragma unroll
          for (int j = 0; j < 8; ++j) { const f32x4 g = ((const f32x4*)g_mem)[64 * j + F.lane]; u32x2 o; o.x = pk2(v[j].x * rs * g.x, v[j].y * rs * g.y); o.y = pk2(v[j].z * rs * g.z, v[j].w * rs * g.w);
              *(u32x2*)(MN + (size_t)row * DM + 4 * (64 * j + F.lane)) = o; } } }
    { const float* x = A.in[0]; bf16* XB = (bf16*)(F.ws + WS_XB); float* ssp = (float*)(F.ws + WS_SSP);
      for (int row = F.gw; row < M; row += F.ngw) { const f32x4* xr = (const f32x4*)(x + (size_t)row * DM) + F.lane; float s = 0.f;
#pragma unroll
          for (int j = 0; j < 8; ++j) { const f32x4 v = __builtin_nontemporal_load(&xr[64 * j]); s += (v.x * v.x + v.y * v.y) + (v.z * v.z + v.w * v.w); u32x2 o; o.x = pk2(v.x, v.y); o.y = pk2(v.z, v.w);
              *(u32x2*)(XB + (size_t)row * DM + 4 * (64 * j + F.lane)) = o;
              if (V_FP8) *(unsigned*)(F.ws + WS_XB8 + (size_t)row * DM + 4 * (64 * j + F.lane)) = pk4f8(v.x, v.y, v.z, v.w); }
          s = wave_sum(s); if (F.lane < 32) ssp[(size_t)row * 32 + F.lane] = F.lane == 0 ? s : 0.f; } }
}

template <class Epi>
__device__ __forceinline__ void ngemm(Frame& F, const bf16* A, const bf16* Bt, int Mr, int N, int K, const Epi& epi) {
    const int fr = F.lane & 15, fq = F.lane >> 4, tilesN = N / 64, tiles = (Mr / 64) * tilesN;
    for (int t = F.gw; t < tiles; t += F.ngw) {
        const int tm = t / tilesN, tn = t % tilesN;
        f32x4 acc[4][4];
#pragma unroll
        for (int i = 0; i < 4; ++i)
#pragma unroll
            for (int j = 0; j < 4; ++j) acc[i][j] = (f32x4){0.f, 0.f, 0.f, 0.f};
        const bf16* Ap = A + (size_t)(tm * 64 + fr) * K + fq * 8; const bf16* Bp = Bt + (size_t)(tn * 64 + fr) * K + fq * 8;
        for (int k0 = 0; k0 < K; k0 += 32) {
            bf16x8 a[4], b[4];
#pragma unroll
            for (int i = 0; i < 4; ++i) a[i] = *(const bf16x8*)(Ap + (size_t)i * 16 * K + k0);
#pragma unroll
            for (int j = 0; j < 4; ++j) b[j] = *(const bf16x8*)(Bp + (size_t)j * 16 * K + k0);
#pragma unroll
            for (int i = 0; i < 4; ++i)
#pragma unroll
                for (int j = 0; j < 4; ++j) acc[i][j] = __builtin_amdgcn_mfma_f32_16x16x32_bf16(b[j], a[i], acc[i][j], 0, 0, 0);
        }
        epi.tile(tm * 64, tn * 64, acc, fr, fq);
    }
}
__device__ __forceinline__ void st4bf(bf16* p, f32x4 v) { u32x2 o; o.x = pk2(v.x, v.y); o.y = pk2(v.z, v.w); *(u32x2*)p = o; }

struct NEpiQKV { const float* ssp; const float* cosT; const float* sinT; bf16 *Q;
    __device__ __forceinline__ void tile(int rb, int cb, f32x4 (&acc)[4][4], int fr, int fq) const {
#pragma unroll
        for (int i = 0; i < 4; ++i) { const int row = rb + 16 * i + fr, b = row >> 12, s = row & 4095; const float rs = rstd_from_ssp(ssp, row, 1.f / DM);
#pragma unroll
            for (int j = 0; j < 4; ++j) { const int n0 = cb + 16 * j + 4 * fq, t = n0 >> 11, head = (n0 >> 7) & 15, p0 = n0 & 127;
                f32x4 v = acc[i][j] * rs, pv;
#pragma unroll
                for (int r = 0; r < 4; ++r) pv[r] = __shfl_xor(v[r], 16);
                if (t < 2 && (head < 4 || head >= 10)) { const int hb = fq & 1, f0 = 4 * (p0 >> 3);
                    const f32x4 c = *(const f32x4*)(cosT + s * 64 + f0), sn = *(const f32x4*)(sinT + s * 64 + f0);
                    v = hb == 0 ? v * c - pv * sn : v * c + pv * sn; }
                if (t == 0) v = v * C2;
                bf16* dst = Q + (size_t)t * ((WS_K - WS_Q) / 2) + (((size_t)(b * 16 + head) * SEQ + s) * HD + p0);
                st4bf(dst, v); } }
    } };
struct NEpiRes { const float* base; float* X; bf16* XB; float* ssp;
    __device__ __forceinline__ void tile(int rb, int cb, f32x4 (&acc)[4][4], int fr, int fq) const {
#pragma unroll
        for (int i = 0; i < 4; ++i) { const int row = rb + 16 * i + fr; float ss = 0.f;
#pragma unroll
            for (int j = 0; j < 4; ++j) { const size_t off = (size_t)row * DM + cb + 16 * j + 4 * fq; const f32x4 xn = *(const f32x4*)(base + off) + acc[i][j];
                *(f32x4*)(X + off) = xn; st4bf(XB + off, xn); ss += (xn.x * xn.x + xn.y * xn.y) + (xn.z * xn.z + xn.w * xn.w); }
            ss += __shfl_xor(ss, 16); ss += __shfl_xor(ss, 32); if (fq == 0) ssp[(size_t)row * 32 + (cb >> 6)] = ss; }
    } };
struct NEpiCq { const float* ssp; bf16* QC;
    __device__ __forceinline__ void tile(int rb, int cb, f32x4 (&acc)[4][4], int fr, int fq) const {
#pragma unroll
        for (int i = 0; i < 4; ++i) { const int row = rb + 16 * i + fr, b = row >> 12, s = row & 4095; const float rs = rstd_from_ssp(ssp, row, 1.f / DM) * C2;
#pragma unroll
            for (int j = 0; j < 4; ++j) { const int n0 = cb + 16 * j + 4 * fq, h = n0 >> 7, d = n0 & 127; st4bf(QC + (((size_t)(b * 4 + h) * SEQ + s) * HD + d), acc[i][j] * rs); } }
    } };
struct NEpiUp { const float* ssp; bf16* ACT;
    __device__ __forceinline__ void tile(int rb, int cb, f32x4 (&acc)[4][4], int fr, int fq) const {
#pragma unroll
        for (int i = 0; i < 4; ++i) { const int row = rb + 16 * i + fr; const float rs = rstd_from_ssp(ssp, row, 1.f / DM);
#pragma unroll
            for (int j = 0; j < 4; ++j) { f32x4 v = acc[i][j] * rs; v.x = fmaxf(v.x, 0.f); v.y = fmaxf(v.y, 0.f); v.z = fmaxf(v.z, 0.f); v.w = fmaxf(v.w, 0.f);
                st4bf(ACT + (size_t)row * FF + cb + 16 * j + 4 * fq, v * v); } }
    } };
struct NEpiCkv { bf16 *CK;
    __device__ __forceinline__ void tile(int rb, int cb, f32x4 (&acc)[4][4], int fr, int fq) const {
#pragma unroll
        for (int i = 0; i < 4; ++i) { const int row = rb + 16 * i + fr, b = row >> 8, m = row & 255;
#pragma unroll
            for (int j = 0; j < 4; ++j) { const int n0 = cb + 16 * j + 4 * fq, l = n0 >> 10, t = (n0 >> 9) & 1, h = (n0 >> 7) & 3, d = n0 & 127;
                st4bf(CK + (size_t)t * ((WS_CV - WS_CK) / 2) + ((((size_t)(l * 4 + b) * 4 + h) * MEML + m) * HD + d), acc[i][j]); } }
    } };

__device__ __forceinline__ void load_q(const bf16* qrow, LAS float* qs, int lane) { const unsigned w = ((const unsigned*)qrow)[lane]; qs[2 * lane] = bflo(w); qs[2 * lane + 1] = bfhi(w); LDS_WAIT(); asm volatile("" ::: "memory"); }
__device__ __forceinline__ float dot_qk(const bf16* krow, const LAS float* qs) {
    float s = 0.f;
#pragma unroll
    for (int c = 0; c < 16; ++c) { const u32x4 w = ((const u32x4*)krow)[c]; const f32x4 q0 = ((const LAS f32x4*)qs)[2 * c], q1 = ((const LAS f32x4*)qs)[2 * c + 1];
        s += bflo(w.x) * q0.x + bfhi(w.x) * q0.y + bflo(w.y) * q0.z + bfhi(w.y) * q0.w + bflo(w.z) * q1.x + bfhi(w.z) * q1.y + bflo(w.w) * q1.z + bfhi(w.w) * q1.w; }
    return s;
}
__device__ __forceinline__ void pv_acc(const bf16* Vh, int k0, int kstep, int cnt, float p, float& o0, float& o1, int lane) {
    for (int s = 0; s < cnt; ++s) { const float ps = __builtin_bit_cast(float, __builtin_amdgcn_readlane(__builtin_bit_cast(int, p), s));
        const unsigned vv = ((const unsigned*)(Vh + (size_t)(k0 + s * kstep) * HD))[lane]; o0 += ps * bflo(vv); o1 += ps * bfhi(vv); }
}
__device__ __forceinline__ void soft_block(const bf16* Kh, const bf16* Vh, int k0, int kstep, int cnt, const LAS float* qs, float& m, float& l, float& o0, float& o1, int lane) {
    float sc = -__builtin_inff(); if (lane < cnt) sc = dot_qk(Kh + (size_t)(k0 + lane * kstep) * HD, qs);
    const float mn = fmaxf(m, wave_max(sc)), alpha = ex2(m - mn), p = lane < cnt ? ex2(sc - mn) : 0.f;
    l = l * alpha + wave_sum(p); o0 *= alpha; o1 *= alpha; m = mn;
    pv_acc(Vh, k0, kstep, cnt, p, o0, o1, lane);
}
__device__ __forceinline__ void naive_kmean(Frame& F) {
    const bf16* K = (const bf16*)(F.ws + WS_K); float* KMP = (float*)(F.ws + WS_KMP);
    for (int it = F.gw; it < BATCH * 4 * 16 * 2; it += F.ngw) { const int half = it & 1, blk = (it >> 1) & 15, bh = it >> 5, b = bh >> 2, h = bh & 3;
        const bf16* kp = K + ((size_t)(b * 16 + h) * SEQ + blk * 256 + half * 128) * HD; float s0 = 0.f, s1 = 0.f;
        for (int r = 0; r < 128; ++r) { const unsigned w = ((const unsigned*)(kp + (size_t)r * HD))[F.lane]; s0 += bflo(w); s1 += bfhi(w); }
        KMP[(size_t)it * HD + 2 * F.lane] = s0; KMP[(size_t)it * HD + 2 * F.lane + 1] = s1; }
}
__device__ __forceinline__ void naive_attention(Frame& F) {
    LAS float* qs = (LAS float*)(F.lds + F.wave * 512);
    const bf16 *Q = (const bf16*)(F.ws + WS_Q), *K = (const bf16*)(F.ws + WS_K), *V = (const bf16*)(F.ws + WS_V);
    bf16 *OA = (bf16*)(F.ws + WS_OA), *OB = (bf16*)(F.ws + WS_OB), *OC = (bf16*)(F.ws + WS_OC); float* LSE = (float*)(F.ws + WS_LSE); const float* KMP = (const float*)(F.ws + WS_KMP);
    const int lane = F.lane;
    for (int it = F.gw; it < BATCH * 4 * SEQ; it += F.ngw) { const int s = it & 4095, bh = it >> 12, b = bh >> 2, h = bh & 3, own = s >> 8;
        const size_t hb = (size_t)(b * 16 + h) * SEQ; const bf16 *Kh = K + hb * HD, *Vh = V + hb * HD;
        load_q(Q + (hb + s) * HD, qs, lane);
        float g[16];
#pragma unroll
        for (int j = 0; j < 16; ++j) { const float* km = KMP + ((size_t)(bh * 16 + j) * 2) * HD;
            const float k0 = (km[2 * lane] + km[HD + 2 * lane]) * (1.f / 256.f), k1 = (km[2 * lane + 1] + km[HD + 2 * lane + 1]) * (1.f / 256.f);
            const float d = wave_sum(qs[2 * lane] * k0 + qs[2 * lane + 1] * k1); g[j] = j < own ? d : -__builtin_inff(); }
        int sel[3];
#pragma unroll
        for (int r = 0; r < 3; ++r) { float best = -__builtin_inff(); int bi = -1;
#pragma unroll
            for (int j = 0; j < 16; ++j) if (g[j] > best) { best = g[j]; bi = j; }
#pragma unroll
            for (int j = 0; j < 16; ++j) if (j == bi) g[j] = -__builtin_inff();
            sel[r] = bi; }
        float m = -1e30f, l = 0.f, o0 = 0.f, o1 = 0.f;
#pragma unroll
        for (int r = 0; r < 3; ++r) if (sel[r] >= 0) for (int c = 0; c < 4; ++c) soft_block(Kh, Vh, sel[r] * 256 + 64 * c, 1, 64, qs, m, l, o0, o1, lane);
        const int n = s - own * 256 + 1;
        for (int c = 0; 64 * c < n; ++c) soft_block(Kh, Vh, own * 256 + 64 * c, 1, (n - 64 * c) < 64 ? (n - 64 * c) : 64, qs, m, l, o0, o1, lane);
        const float il = 1.f / l; ((unsigned*)(OA + (size_t)(b * SEQ + s) * 512 + h * HD))[lane] = pk2(o0 * il, o1 * il); }
    for (int it = F.gw; it < BATCH * 6 * SEQ; it += F.ngw) { const int s = it & 4095, bh = it >> 12, b = bh / 6, h = 4 + bh % 6;
        const size_t hb = (size_t)(b * 16 + h) * SEQ; const bf16 *Kh = K + hb * HD, *Vh = V + hb * HD;
        load_q(Q + (hb + s) * HD, qs, lane);
        float carry = 0.f, o0 = 0.f, o1 = 0.f;
        for (int c = 0; 64 * c < s; ++c) { const int cnt = (s - 64 * c) < 64 ? (s - 64 * c) : 64, k0 = s - 1 - 64 * c;
            float y = 0.f, sp = 0.f; if (lane < cnt) { y = dot_qk(Kh + (size_t)(k0 - lane) * HD, qs); sp = fmaxf(y, 0.f) + lg2(1.f + ex2(-fabsf(y))); }
            float inc = sp;
#pragma unroll
            for (int o = 1; o < 64; o <<= 1) { const float t = __shfl_up(inc, o); if (lane >= o) inc += t; }
            const float w = lane < cnt ? ex2(y - (carry + inc)) : 0.f;
            carry += __shfl(inc, 63);
            pv_acc(Vh, k0, -1, cnt, w, o0, o1, lane); }
        ((unsigned*)(OB + (size_t)(b * SEQ + s) * 768 + (h - 4) * HD))[lane] = pk2(o0, o1); }
    for (int it = F.gw; it < BATCH * 6 * SEQ; it += F.ngw) { const int s = it & 4095, bh = it >> 12, b = bh / 6, hc = bh % 6, h = 10 + hc, g = hc >> 1, jj = hc & 1, d = g == 0 ? 1 : (g == 1 ? 4 : 16);
        const size_t hb = (size_t)(b * 16 + h) * SEQ; const bf16 *Kh = K + hb * HD, *Vh = V + hb * HD;
        load_q(Q + (hb + s) * HD, qs, lane);
        const int pm = s / d, nk = (pm < 128 ? pm : 128) + 1;
        float m = -1e30f, l = 0.f, o0 = 0.f, o1 = 0.f;
        for (int c = 0; 64 * c < nk; ++c) soft_block(Kh, Vh, s - 64 * c * d, -d, (nk - 64 * c) < 64 ? (nk - 64 * c) : 64, qs, m, l, o0, o1, lane);
        const float il = 1.f / l; const size_t row = (size_t)(b * SEQ + s);
        ((unsigned*)(OC + ((size_t)g * M + row) * 256 + jj * HD))[lane] = pk2(o0 * il, o1 * il);
        if (lane == 0) LSE[((size_t)g * M + row) * 2 + jj] = m + lg2(l); }
}
__device__ __forceinline__ void naive_xattn(Frame& F, int layer) {
    LAS float* qs = (LAS float*)(F.lds + F.wave * 512); const int lane = F.lane;
    const bf16 *QC = (const bf16*)(F.ws + WS_QC), *CK = (const bf16*)(F.ws + WS_CK), *CV = (const bf16*)(F.ws + WS_CV); bf16* OCR = (bf16*)(F.ws + WS_OCR);
    for (int it = F.gw; it < BATCH * 4 * SEQ; it += F.ngw) { const int s = it & 4095, bh = it >> 12, b = bh >> 2, h = bh & 3;
        const size_t kb = ((size_t)(layer * 4 + b) * 4 + h) * MEML * HD; const bf16 *Kh = CK + kb, *Vh = CV + kb;
        load_q(QC + ((size_t)bh * SEQ + s) * HD, qs, lane);
        float m = -1e30f, l = 0.f, o0 = 0.f, o1 = 0.f;
        for (int c = 0; c < 4; ++c) soft_block(Kh, Vh, 64 * c, 1, 64, qs, m, l, o0, o1, lane);
        const float il = 1.f / l; ((unsigned*)(OCR + (size_t)(b * SEQ + s) * CW + h * HD))[lane] = pk2(o0 * il, o1 * il); }
}
__device__ __forceinline__ void phase_merge(Frame& F) {
    const bf16 *OA = (const bf16*)(F.ws + WS_OA), *OB = (const bf16*)(F.ws + WS_OB), *OC = (const bf16*)(F.ws + WS_OC); const float* LSE = (const float*)(F.ws + WS_LSE); bf16* MRG = (bf16*)(F.ws + WS_MRG);
    const int lane = F.lane, jj = lane >> 5;
    for (int row0 = F.gw; row0 < M; row0 += 2 * F.ngw) {
        const bool two = row0 + F.ngw < M;
        u32x4 wa[2]; u32x2 wb[2][3], wc[2][3]; float ls[2][3];
#if MOBA_GATHER
        u32x4 wp[2][3]; float lp[2][4];
#endif
#pragma unroll
        for (int q = 0; q < 2; ++q) { const int row = (q && two) ? row0 + F.ngw : row0;
#if MOBA_GATHER
            wa[q] = ((const u32x4*)((const bf16*)(F.ws + WS_PART) + ((size_t)3 * M + row) * 512))[lane];
#pragma unroll
            for (int sl = 0; sl < 3; ++sl) wp[q][sl] = ((const u32x4*)((const bf16*)(F.ws + WS_PART) + ((size_t)sl * M + row) * 512))[lane];
#pragma unroll
            for (int sl = 0; sl < 4; ++sl) lp[q][sl] = ((const float*)(F.ws + WS_PLSE))[((size_t)sl * M + row) * 4 + (lane >> 4)];
#else
            wa[q] = ((const u32x4*)(OA + (size_t)row * 512))[lane];
#endif
#pragma unroll
            for (int k = 0; k < 3; ++k) { wb[q][k] = ((const u32x2*)(OB + (size_t)row * 768))[lane + 64 * k]; wc[q][k] = ((const u32x2*)(OC + ((size_t)k * M + row) * 256))[lane]; ls[q][k] = LSE[((size_t)k * M + row) * 2 + jj]; } }
#if OUT_I8
#pragma unroll
        for (int q = 0; q < 2; ++q) { const int row = row0 + q * F.ngw; if (q && !two) break;
            float va[8], vb[12], vc[4]; float amax;
            { const u32x4 w = wa[q]; float v[8] = {bflo(w.x), bfhi(w.x), bflo(w.y), bfhi(w.y), bflo(w.z), bfhi(w.z), bflo(w.w), bfhi(w.w)}; float ss = 0.f;
#if MOBA_GATHER
              { const float mxl = fmaxf(fmaxf(lp[q][0], lp[q][1]), fmaxf(lp[q][2], lp[q][3])); float wt[4], wsum = 0.f;
#pragma unroll
                for (int sl = 0; sl < 4; ++sl) { wt[sl] = ex2(lp[q][sl] - mxl); wsum += wt[sl]; }
                const float iw = 1.f / wsum;
#pragma unroll
                for (int i = 0; i < 8; ++i) v[i] *= wt[3] * iw;
#pragma unroll
                for (int sl = 0; sl < 3; ++sl) { const u32x4 x = wp[q][sl]; const float a = wt[sl] * iw; const float pv[8] = {bflo(x.x), bfhi(x.x), bflo(x.y), bfhi(x.y), bflo(x.z), bfhi(x.z), bflo(x.w), bfhi(x.w)};
#pragma unroll
                    for (int i = 0; i < 8; ++i) v[i] += a > 0.f ? a * pv[i] : 0.f; } }
#endif
#pragma unroll
              for (int i = 0; i < 8; ++i) ss += v[i] * v[i];
              const float rs = 1.0f / sqrtf(wave_sum(ss) * (1.f / 512.f) + EPS); amax = 0.f;
#pragma unroll
              for (int i = 0; i < 8; ++i) { va[i] = v[i] * rs; amax = fmaxf(amax, fabsf(va[i])); } }
            { float ss = 0.f;
#pragma unroll
              for (int k = 0; k < 3; ++k) { const u32x2 w = wb[q][k]; vb[4 * k] = bflo(w.x); vb[4 * k + 1] = bfhi(w.x); vb[4 * k + 2] = bflo(w.y); vb[4 * k + 3] = bfhi(w.y); }
#pragma unroll
              for (int i = 0; i < 12; ++i) ss += vb[i] * vb[i];
              const float rs = 1.0f / sqrtf(wave_sum(ss) * (1.f / 768.f) + EPS);
#pragma unroll
              for (int i = 0; i < 12; ++i) { vb[i] *= rs; amax = fmaxf(amax, fabsf(vb[i])); } }
            { float mx = fmaxf(fmaxf(ls[q][0], ls[q][1]), ls[q][2]); float a[3], as = 0.f;
#pragma unroll
              for (int g = 0; g < 3; ++g) { a[g] = ex2(ls[q][g] - mx); as += a[g]; }
              const float ia = 1.f / as; float v[4] = {0.f, 0.f, 0.f, 0.f};
#pragma unroll
              for (int g = 0; g < 3; ++g) { const u32x2 w = wc[q][g]; const float al = a[g] * ia; v[0] += al * bflo(w.x); v[1] += al * bfhi(w.x); v[2] += al * bflo(w.y); v[3] += al * bfhi(w.y); }
              const float ss = (v[0] * v[0] + v[1] * v[1]) + (v[2] * v[2] + v[3] * v[3]);
              const float rs = 1.0f / sqrtf(wave_sum(ss) * (1.f / 256.f) + EPS);
#pragma unroll
              for (int i = 0; i < 4; ++i) { vc[i] = v[i] * rs; amax = fmaxf(amax, fabsf(vc[i])); } }
            amax = wave_max(amax); const float inv = amax > 0.f ? 127.f / amax : 0.f;
            if (lane == 0) ((float*)(F.ws + WS_RSC))[row] = amax * (1.f / 127.f);
            unsigned char* mr = (unsigned char*)MRG + (size_t)row * OW;
            { u32x2 o; o.x = pk4i8(va[0] * inv, va[1] * inv, va[2] * inv, va[3] * inv); o.y = pk4i8(va[4] * inv, va[5] * inv, va[6] * inv, va[7] * inv); ((u32x2*)mr)[lane] = o; }
#pragma unroll
            for (int k = 0; k < 3; ++k) ((unsigned*)(mr + 512))[lane + 64 * k] = pk4i8(vb[4 * k] * inv, vb[4 * k + 1] * inv, vb[4 * k + 2] * inv, vb[4 * k + 3] * inv);
            ((unsigned*)(mr + 1280))[lane] = pk4i8(vc[0] * inv, vc[1] * inv, vc[2] * inv, vc[3] * inv); }
#else
#pragma unroll
        for (int q = 0; q < 2; ++q) { const int row = row0 + q * F.ngw; if (q && !two) break;
            { const u32x4 w = wa[q]; float v[8] = {bflo(w.x), bfhi(w.x), bflo(w.y), bfhi(w.y), bflo(w.z), bfhi(w.z), bflo(w.w), bfhi(w.w)}; float ss = 0.f;
#pragma unroll
              for (int i = 0; i < 8; ++i) ss += v[i] * v[i];
              const float rs = 1.0f / sqrtf(wave_sum(ss) * (1.f / 512.f) + EPS); u32x4 o; o.x = pk2(v[0] * rs, v[1] * rs); o.y = pk2(v[2] * rs, v[3] * rs); o.z = pk2(v[4] * rs, v[5] * rs); o.w = pk2(v[6] * rs, v[7] * rs);
              ((u32x4*)(MRG + (size_t)row * OW))[lane] = o; }
            { float v[12]; float ss = 0.f;
#pragma unroll
              for (int k = 0; k < 3; ++k) { const u32x2 w = wb[q][k]; v[4 * k] = bflo(w.x); v[4 * k + 1] = bfhi(w.x); v[4 * k + 2] = bflo(w.y); v[4 * k + 3] = bfhi(w.y); }
#pragma unroll
              for (int i = 0; i < 12; ++i) ss += v[i] * v[i];
              const float rs = 1.0f / sqrtf(wave_sum(ss) * (1.f / 768.f) + EPS);
#pragma unroll
              for (int k = 0; k < 3; ++k) { u32x2 o; o.x = pk2(v[4 * k] * rs, v[4 * k + 1] * rs); o.y = pk2(v[4 * k + 2] * rs, v[4 * k + 3] * rs); ((u32x2*)(MRG + (size_t)row * OW + 512))[lane + 64 * k] = o; } }
            { float mx = fmaxf(fmaxf(ls[q][0], ls[q][1]), ls[q][2]); float a[3], as = 0.f;
#pragma unroll
              for (int g = 0; g < 3; ++g) { a[g] = ex2(ls[q][g] - mx); as += a[g]; }
              const float ia = 1.f / as; float v[4] = {0.f, 0.f, 0.f, 0.f};
#pragma unroll
              for (int g = 0; g < 3; ++g) { const u32x2 w = wc[q][g]; const float al = a[g] * ia; v[0] += al * bflo(w.x); v[1] += al * bfhi(w.x); v[2] += al * bflo(w.y); v[3] += al * bfhi(w.y); }
              const float ss = (v[0] * v[0] + v[1] * v[1]) + (v[2] * v[2] + v[3] * v[3]);
              const float rs = 1.0f / sqrtf(wave_sum(ss) * (1.f / 256.f) + EPS); u32x2 o; o.x = pk2(v[0] * rs, v[1] * rs); o.y = pk2(v[2] * rs, v[3] * rs);
              ((u32x2*)(MRG + (size_t)row * OW + 1280))[lane] = o; } }
#endif
    }
}
__device__ __forceinline__ void phase_final(Frame& F, const float* gf) {
    const float* ssp = (const float*)(F.ws + WS_SSP); const bf16* XB = (const bf16*)(F.ws + WS_XB);
    for (int row0 = F.gw; row0 < M; row0 += 2 * F.ngw) {
        const bool two = row0 + F.ngw < M; u32x4 w[2][4]; float ssq[2];
#pragma unroll
        for (int q = 0; q < 2; ++q) { const int row = (q && two) ? row0 + F.ngw : row0; const u32x4* xr = (const u32x4*)(XB + (size_t)row * DM) + F.lane;
#pragma unroll
            for (int j = 0; j < 4; ++j) w[q][j] = xr[64 * j];
            ssq[q] = ssp[(size_t)row * 32 + (F.lane & 31)]; }
#pragma unroll
        for (int q = 0; q < 2; ++q) { const int row = row0 + q * F.ngw; if (q && !two) break;
            float s = ssq[q]; s += xor_lane<1>(s); s += xor_lane<2>(s); s += xor_lane<4>(s); s += xor_lane<8>(s); s += xor_lane<16>(s);
            const float rs = 1.0f / sqrtf(s * (1.f / DM) + EPS); f32x4* orow = (f32x4*)(F.X + (size_t)row * DM);
#pragma unroll
            for (int j = 0; j < 4; ++j) { const u32x4 ww = w[q][j]; const int e = 2 * (64 * j + F.lane); const f32x4 g0 = ((const f32x4*)gf)[e], g1 = ((const f32x4*)gf)[e + 1];
                orow[e] = (f32x4){bflo(ww.x) * rs * g0.x, bfhi(ww.x) * rs * g0.y, bflo(ww.y) * rs * g0.z, bfhi(ww.y) * rs * g0.w};
                orow[e + 1] = (f32x4){bflo(ww.z) * rs * g1.x, bfhi(ww.z) * rs * g1.y, bflo(ww.w) * rs * g1.z, bfhi(ww.w) * rs * g1.w}; } }
    }
}

namespace att {
typedef float f32x16 __attribute__((ext_vector_type(16)));
typedef short s16x4 __attribute__((ext_vector_type(4)));
constexpr int SHM = 16384;
constexpr int OFF_V = 0, OFF_K = 2 * SHM, OFF_WS = 4 * SHM, OFF_FLAG = OFF_WS + 8 * 256, OFF_SLOT = 137216  , ATT_LDS = OFF_FLAG + 64;
#define SBAR() __builtin_amdgcn_sched_barrier(0)
__device__ __forceinline__ int kswz(int row, int colB) { return row * 256 + (colB ^ ((row & 7) << 4)); }
__device__ __forceinline__ int v_st(int k, int c) { const int kk = (k & ~0xC) | ((k & 4) << 1) | ((k & 8) >> 1); return ((kk >> 3) * 4 + (c >> 5)) * 512 + ((kk & 7) * 32 + (c & 31)) * 2; }
__device__ __forceinline__ int v_rd_base(int lane) { return ((lane & 3) << 3) | (((lane >> 2) & 3) << 6) | (((lane >> 4) & 1) << 5) | (((lane >> 5) & 1) << 8); }
constexpr int v_rd_off(int d0, int ks, int half) { return d0 * 512 + ks * 4096 + half * 2048; }
__device__ __forceinline__ int crow(int r, int hi) { return (r & 3) + 8 * (r >> 2) + 4 * hi; }
__device__ __forceinline__ unsigned cvtpk(float lo, float hi) { unsigned r; asm volatile("v_cvt_pk_bf16_f32 %0, %1, %2" : "=v"(r) : "v"(lo), "v"(hi)); return r; }
__device__ __forceinline__ float swap_sum(float v) { float w = v; asm volatile("" : "+v"(w)); auto rr = __builtin_amdgcn_permlane32_swap(__float_as_uint(v), __float_as_uint(w), false, false); return __uint_as_float(rr[0]) + __uint_as_float(rr[1]); }
__device__ __forceinline__ float swap_max(float v) { float w = v; asm volatile("" : "+v"(w)); auto rr = __builtin_amdgcn_permlane32_swap(__float_as_uint(v), __float_as_uint(w), false, false); return fmaxf(__uint_as_float(rr[0]), __uint_as_float(rr[1])); }

template <int KB, bool BOTH>
__device__ __forceinline__ void qkt(f32x16& p0, f32x16& p1, const LAS char* K_lds, int r32, int hi, const bf16x8* qr) {
    unsigned ka[4];
#pragma unroll
    for (int dd = 0; dd < 4; ++dd) ka[dd] = (unsigned)(size_t)K_lds + (unsigned)kswz(r32, (dd * 16 + hi * 8) * 2);
#define KRD(dst, dd, off) asm volatile("ds_read_b128 %0, %1 offset:%2" : "=&v"(dst) : "v"(ka[dd]), "i"(KB * SHM + (off)) : "memory")
#define KWAIT(n) do { SBAR(); asm volatile("s_waitcnt lgkmcnt(" #n ")" ::: "memory"); SBAR(); } while (0)
    if (BOTH) {
        bf16x8 A0, A1, A2, A3, B0, B1, B2, B3, C0, C1, C2, C3;
        KRD(A0, 0, 0); KRD(A1, 0, 8192); KRD(A2, 1, 0); KRD(A3, 1, 8192);
        KRD(B0, 2, 0); KRD(B1, 2, 8192); KRD(B2, 3, 0); KRD(B3, 3, 8192);
        KWAIT(4);
        asm("v_mfma_f32_32x32x16_bf16 %0, %1, %2, 0" : "=&v"(p0) : "v"(A0), "v"(qr[0])); asm("v_mfma_f32_32x32x16_bf16 %0, %1, %2, 0" : "=&v"(p1) : "v"(A1), "v"(qr[0]));
        p0 = __builtin_amdgcn_mfma_f32_32x32x16_bf16(A2, qr[1], p0, 0, 0, 0); p1 = __builtin_amdgcn_mfma_f32_32x32x16_bf16(A3, qr[1], p1, 0, 0, 0);
        SBAR(); KRD(C0, 0, 128); KRD(C1, 0, 128 + 8192); KRD(C2, 1, 128); KRD(C3, 1, 128 + 8192);
        KWAIT(4);
        p0 = __builtin_amdgcn_mfma_f32_32x32x16_bf16(B0, qr[2], p0, 0, 0, 0); p1 = __builtin_amdgcn_mfma_f32_32x32x16_bf16(B1, qr[2], p1, 0, 0, 0);
        p0 = __builtin_amdgcn_mfma_f32_32x32x16_bf16(B2, qr[3], p0, 0, 0, 0); p1 = __builtin_amdgcn_mfma_f32_32x32x16_bf16(B3, qr[3], p1, 0, 0, 0);
        SBAR(); KRD(A0, 2, 128); KRD(A1, 2, 128 + 8192); KRD(A2, 3, 128); KRD(A3, 3, 128 + 8192);
        KWAIT(4);
        p0 = __builtin_amdgcn_mfma_f32_32x32x16_bf16(C0, qr[4], p0, 0, 0, 0); p1 = __builtin_amdgcn_mfma_f32_32x32x16_bf16(C1, qr[4], p1, 0, 0, 0);
        p0 = __builtin_amdgcn_mfma_f32_32x32x16_bf16(C2, qr[5], p0, 0, 0, 0); p1 = __builtin_amdgcn_mfma_f32_32x32x16_bf16(C3, qr[5], p1, 0, 0, 0);
        KWAIT(0);
        p0 = __builtin_amdgcn_mfma_f32_32x32x16_bf16(A0, qr[6], p0, 0, 0, 0); p1 = __builtin_amdgcn_mfma_f32_32x32x16_bf16(A1, qr[6], p1, 0, 0, 0);
        p0 = __builtin_amdgcn_mfma_f32_32x32x16_bf16(A2, qr[7], p0, 0, 0, 0); p1 = __builtin_amdgcn_mfma_f32_32x32x16_bf16(A3, qr[7], p1, 0, 0, 0);
    } else {
        bf16x8 A0, A1, A2, A3, B0, B1, B2, B3;
        KRD(A0, 0, 0); KRD(A1, 1, 0); KRD(A2, 2, 0); KRD(A3, 3, 0); KRD(B0, 0, 128); KRD(B1, 1, 128); KRD(B2, 2, 128); KRD(B3, 3, 128);
        KWAIT(4);
        asm("v_mfma_f32_32x32x16_bf16 %0, %1, %2, 0" : "=&v"(p0) : "v"(A0), "v"(qr[0]));
        p0 = __builtin_amdgcn_mfma_f32_32x32x16_bf16(A1, qr[1], p0, 0, 0, 0); p0 = __builtin_amdgcn_mfma_f32_32x32x16_bf16(A2, qr[2], p0, 0, 0, 0); p0 = __builtin_amdgcn_mfma_f32_32x32x16_bf16(A3, qr[3], p0, 0, 0, 0);
        KWAIT(0);
        p0 = __builtin_amdgcn_mfma_f32_32x32x16_bf16(B0, qr[4], p0, 0, 0, 0); p0 = __builtin_amdgcn_mfma_f32_32x32x16_bf16(B1, qr[5], p0, 0, 0, 0);
        p0 = __builtin_amdgcn_mfma_f32_32x32x16_bf16(B2, qr[6], p0, 0, 0, 0); p0 = __builtin_amdgcn_mfma_f32_32x32x16_bf16(B3, qr[7], p0, 0, 0, 0);
        { float z = 0.f; asm volatile("" : "+v"(z));
#pragma unroll
          for (int r = 0; r < 16; ++r) p1[r] = z; }
    }
#undef KRD
#undef KWAIT
}
template <int VB>
__device__ __forceinline__ void pv_tile(f32x16* o, unsigned vb0, bf16x8 pa0, bf16x8 pa1, bf16x8 pa2, bf16x8 pa3) {
#define TRRD(dst, off) asm volatile("ds_read_b64_tr_b16 %0, %1 offset:%2" : "=&v"(dst) : "v"(vb0), "i"(off) : "memory")
#define PV_LD(S, d0) do { constexpr int b_ = OFF_V + VB * SHM + v_rd_off(d0, 0, 0); \
        TRRD(S##l0, b_); TRRD(S##h0, b_ + 2048); TRRD(S##l1, b_ + 4096); TRRD(S##h1, b_ + 6144); TRRD(S##l2, b_ + 8192); TRRD(S##h2, b_ + 10240); TRRD(S##l3, b_ + 12288); TRRD(S##h3, b_ + 14336); } while (0)
#define PV_MM(S, d0) do { \
        o[d0] = __builtin_amdgcn_mfma_f32_32x32x16_bf16(pa0, (bf16x8){S##l0[0], S##l0[1], S##l0[2], S##l0[3], S##h0[0], S##h0[1], S##h0[2], S##h0[3]}, o[d0], 0, 0, 0); \
        o[d0] = __builtin_amdgcn_mfma_f32_32x32x16_bf16(pa1, (bf16x8){S##l1[0], S##l1[1], S##l1[2], S##l1[3], S##h1[0], S##h1[1], S##h1[2], S##h1[3]}, o[d0], 0, 0, 0); \
        o[d0] = __builtin_amdgcn_mfma_f32_32x32x16_bf16(pa2, (bf16x8){S##l2[0], S##l2[1], S##l2[2], S##l2[3], S##h2[0], S##h2[1], S##h2[2], S##h2[3]}, o[d0], 0, 0, 0); \
        o[d0] = __builtin_amdgcn_mfma_f32_32x32x16_bf16(pa3, (bf16x8){S##l3[0], S##l3[1], S##l3[2], S##l3[3], S##h3[0], S##h3[1], S##h3[2], S##h3[3]}, o[d0], 0, 0, 0); } while (0)
    s16x4 Al0, Al1, Al2, Al3, Ah0, Ah1, Ah2, Ah3, Bl0, Bl1, Bl2, Bl3, Bh0, Bh1, Bh2, Bh3;
    PV_LD(A, 0);
    PV_LD(B, 1); asm volatile("s_waitcnt lgkmcnt(8)" ::: "memory"); SBAR(); PV_MM(A, 0); SBAR();
    PV_LD(A, 2); asm volatile("s_waitcnt lgkmcnt(8)" ::: "memory"); SBAR(); PV_MM(B, 1); SBAR();
    PV_LD(B, 3); asm volatile("s_waitcnt lgkmcnt(8)" ::: "memory"); SBAR(); PV_MM(A, 2); SBAR();
    asm volatile("s_waitcnt lgkmcnt(0)" ::: "memory"); SBAR(); PV_MM(B, 3);
#undef PV_MM
#undef PV_LD
#undef TRRD
}
__device__ __forceinline__ void pack_p(const f32x16& p0, const f32x16& p1, bf16x8& pa0, bf16x8& pa1, bf16x8& pa2, bf16x8& pa3) {
#define PK4(P, B_, OUT) do { unsigned a0 = cvtpk(P[B_+0], P[B_+1]), a1 = cvtpk(P[B_+2], P[B_+3]); unsigned b0 = cvtpk(P[B_+4], P[B_+5]), b1 = cvtpk(P[B_+6], P[B_+7]); \
        auto r0 = __builtin_amdgcn_permlane32_swap(a0, b0, false, false); auto r1 = __builtin_amdgcn_permlane32_swap(a1, b1, false, false); \
        u32x4 w = {r0[0], r1[0], r0[1], r1[1]}; OUT = *reinterpret_cast<bf16x8*>(&w); } while (0)
    PK4(p0, 0, pa0); PK4(p0, 8, pa1); PK4(p1, 0, pa2); PK4(p1, 8, pa3);
#undef PK4
}
__device__ __forceinline__ void mask_tile(f32x16& p0, f32x16& p1, int dq, unsigned W) {
    const float NEG = -__builtin_inff();
#pragma unroll
    for (int r = 0; r < 16; ++r) { const int c = (r & 3) + 8 * (r >> 2); if ((unsigned)(dq - c) >= W) p0[r] = NEG; if ((unsigned)(dq - c - 32) >= W) p1[r] = NEG; }
}
__device__ __forceinline__ void softmax_tile(f32x16& p0, f32x16& p1, float& m_reg, float& l_reg, float& alpha) {
    float pmax = p0[0];
#pragma unroll
    for (int r = 1; r < 16; ++r) pmax = fmaxf(pmax, p0[r]);
#pragma unroll
    for (int r = 0; r < 16; ++r) pmax = fmaxf(pmax, p1[r]);
    pmax = swap_max(pmax);
    const float mn = pmax > m_reg + 8.f ? pmax : m_reg; alpha = ex2(m_reg - mn); m_reg = mn;
    float ps = 0.f;
#pragma unroll
    for (int r = 0; r < 16; ++r) { p0[r] = ex2(p0[r] - mn); ps += p0[r]; }
#pragma unroll
    for (int r = 0; r < 16; ++r) { p1[r] = ex2(p1[r] - mn); ps += p1[r]; }
    l_reg = l_reg * alpha + swap_sum(ps);
}
__device__ __forceinline__ void sb_tile(f32x16& p0, f32x16& p1, int dq, int hi, float& carry) {
    float s0[16], s1[16];
#pragma unroll
    for (int r = 0; r < 16; ++r) { const int c = (r & 3) + 8 * (r >> 2);
        { const float y = p0[r]; const float sp = fmaxf(y, 0.f) + lg2(1.f + ex2(-fabsf(y))); s0[r] = (dq - c) >= 0 ? sp : 0.f; }
        { const float y = p1[r]; const float sp = fmaxf(y, 0.f) + lg2(1.f + ex2(-fabsf(y))); s1[r] = (dq - c - 32) >= 0 ? sp : 0.f; } }
    float T0[4], T1[4], c0[4], c1[4];
#pragma unroll
    for (int g = 0; g < 4; ++g) {
        s0[4 * g + 2] += s0[4 * g + 3]; s0[4 * g + 1] += s0[4 * g + 2]; s0[4 * g] += s0[4 * g + 1]; T0[g] = s0[4 * g]; c0[g] = swap_sum(T0[g]);
        s1[4 * g + 2] += s1[4 * g + 3]; s1[4 * g + 1] += s1[4 * g + 2]; s1[4 * g] += s1[4 * g + 1]; T1[g] = s1[4 * g]; c1[g] = swap_sum(T1[g]); }
    float A1[4], A0[4]; A1[3] = 0.f; A1[2] = c1[3]; A1[1] = A1[2] + c1[2]; A1[0] = A1[1] + c1[1]; const float tot1 = A1[0] + c1[0];
    A0[3] = 0.f; A0[2] = c0[3]; A0[1] = A0[2] + c0[2]; A0[0] = A0[1] + c0[1]; const float tot0 = A0[0] + c0[0];
    const float base1 = carry, base0 = carry + tot1;
#pragma unroll
    for (int g = 0; g < 4; ++g) { const float ab1 = base1 + A1[g] + (hi == 0 ? c1[g] - T1[g] : 0.f), ab0 = base0 + A0[g] + (hi == 0 ? c0[g] - T0[g] : 0.f);
#pragma unroll
        for (int i = 0; i < 4; ++i) { const int r = 4 * g + i, c = (r & 3) + 8 * (r >> 2);
            p1[r] = (dq - c - 32) >= 0 ? ex2(p1[r] - (ab1 + s1[r])) : 0.f;
            p0[r] = (dq - c) >= 0 ? ex2(p0[r] - (ab0 + s0[r])) : 0.f; } }
    carry += tot1 + tot0;
}

struct PolCross { __device__ __forceinline__ int ntiles() const { return 4; } __device__ __forceinline__ int tile_base(int t) const { return 64 * t; } };
struct PolDil { int tb0, nt; __device__ __forceinline__ int ntiles() const { return nt; } __device__ __forceinline__ int tile_base(int t) const { return tb0 + 64 * t; } };
struct PolMoba { int own; __device__ __forceinline__ int ntiles() const { return 4 * (own + 1); } __device__ __forceinline__ int tile_base(int t) const { return 64 * t; } };
struct PolSB { int qi0; __device__ __forceinline__ int ntiles() const { return (qi0 + 256) >> 6; } __device__ __forceinline__ int tile_base(int t) const { return qi0 + 192 - 64 * t; } };
constexpr float SB_DONE = 48.f;

template <int MODE, class Pol>
__device__ __forceinline__ void attn_unit(LAS char* lds, const bf16* Qh, const bf16* Kh, const bf16* Vh, int stride, int res, int qi0, const Pol P,
                                          bf16* O, int opitch, float* L, const float* kmp  , const int wid) {
    const int lane_ = lane_id();
    const int lane = lane_, tid = wid * 64 + lane, r32 = lane & 31, hi = lane >> 5;
    LAS char* V_lds = lds + OFF_V; LAS char* K_lds = lds + OFF_K; LAS float* wsx = (LAS float*)(lds + OFF_WS) + wid * 64; LAS float* li_l = wsx; LAS float* al_l = wsx + 32;
    volatile LAS unsigned* flags = (volatile LAS unsigned*)(lds + OFF_FLAG);
    const int qw = qi0 + wid * 32;
    bf16x8 qr[8];
    { const bf16* qp = Qh + ((size_t)((qw + r32) * stride + res)) * HD + hi * 8;
#pragma unroll
      for (int d0 = 0; d0 < 8; ++d0) qr[d0] = *(const bf16x8*)(qp + d0 * 16); }
    const int sr = tid >> 4, sc = (tid & 15) * 8, vst0 = v_st(sr, sc), vst1 = v_st(32 + sr, sc), kws = kswz(sr, sc * 2);
    const unsigned vb0 = (unsigned)(size_t)lds + v_rd_base(lane);
    bf16x8 st_k0, st_k1, st_v0, st_v1;
#define TLOAD(t) do { const int tb_ = P.tile_base(t); const size_t a0_ = ((size_t)((tb_ + sr) * stride + res)) * HD + sc, a1_ = ((size_t)((tb_ + 32 + sr) * stride + res)) * HD + sc; \
        st_k0 = *(const bf16x8*)(Kh + a0_); st_k1 = *(const bf16x8*)(Kh + a1_); st_v0 = *(const bf16x8*)(Vh + a0_); st_v1 = *(const bf16x8*)(Vh + a1_); } while (0)
#define TWRITE(bf) do { *(LAS bf16x8*)(K_lds + (bf) * SHM + kws) = st_k0; *(LAS bf16x8*)(K_lds + (bf) * SHM + kws + 32 * 256) = st_k1; \
        *(LAS bf16x8*)(V_lds + (bf) * SHM + vst0) = st_v0; *(LAS bf16x8*)(V_lds + (bf) * SHM + vst1) = st_v1; } while (0)
    const int NT = P.ntiles();
    unsigned selbits = 0u;
    TLOAD(0);
    if constexpr (MODE == 2) {
        { const int row = tid >> 4, blk = row & 15, lo = row >> 4; const float* km = kmp + (size_t)blk * 2 * HD + sc; float v[8];
#pragma unroll
          for (int i = 0; i < 8; ++i) { v[i] = (km[i] + km[HD + i]) * (1.f / 256.f); const float h = __uint_as_float(f2bf(v[i]) << 16); v[i] = lo ? v[i] - h : h; }
          u32x4 w; w.x = pk2(v[0], v[1]); w.y = pk2(v[2], v[3]); w.z = pk2(v[4], v[5]); w.w = pk2(v[6], v[7]);
          *(LAS u32x4*)(K_lds + kswz(row, sc * 2)) = w; }
        __syncthreads();
        f32x16 g0, g1; qkt<0, false>(g0, g1, K_lds, r32, hi, qr);
        float gown[8], goth[8];
#pragma unroll
        for (int r = 0; r < 8; ++r) { gown[r] = g0[r] + g0[r + 8]; goth[r] = get_xor32(gown[r], hi); }
        float g16[16];
#pragma unroll
        for (int a = 0; a < 2; ++a)
#pragma unroll
            for (int h2 = 0; h2 < 2; ++h2)
#pragma unroll
                for (int i = 0; i < 4; ++i) { const int blk = 8 * a + 4 * h2 + i; const float v = (h2 == hi) ? gown[4 * a + i] : goth[4 * a + i]; g16[blk] = blk < P.own ? v : -__builtin_inff(); }
#pragma unroll
        for (int rk = 0; rk < 3; ++rk) { float best = -__builtin_inff(); int bi = -1;
#pragma unroll
            for (int j = 0; j < 16; ++j) if (g16[j] > best) { best = g16[j]; bi = j; }
#pragma unroll
            for (int j = 0; j < 16; ++j) if (j == bi) g16[j] = -__builtin_inff();
            if (bi >= 0) selbits |= 1u << bi; }
        __syncthreads();
    }
    TWRITE(0);
    __syncthreads();
    float m_reg = -1e30f, l_reg = 0.f, carry = 0.f; f32x16 o[4];
    { float z = 0.f; asm volatile("" : "+v"(z));
#pragma unroll
      for (int r = 0; r < 16; ++r) { o[0][r] = z; o[1][r] = z; o[2][r] = z; o[3][r] = z; } }
    bool done = false;
#define STEP(t, B) do { const int tb = P.tile_base(t); const bool more = (t) + 1 < NT; \
        if (more) TLOAD((t) + 1); \
        bool act = true; \
        if (MODE == 1) act = (tb <= qw + 31) && (tb + 63 >= qw - 128); \
        if constexpr (MODE == 2) { const int blk = (t) >> 2; act = blk < P.own ? (__any((selbits >> blk) & 1u) != 0) : (tb <= qw + 31); } \
        if (MODE == 3) act = (tb <= qw + 30) && !done; \
        if (act) { f32x16 p0, p1; qkt<B, true>(p0, p1, K_lds, r32, hi, qr); bf16x8 pa0, pa1, pa2, pa3; \
            if (MODE == 3) { sb_tile(p0, p1, qw + r32 - 1 - tb - 4 * hi, hi, carry); done = __all(carry > SB_DONE) != 0; } \
            else { \
                if (MODE == 1) mask_tile(p0, p1, qw + r32 - tb - 4 * hi, 129u); \
                if constexpr (MODE == 2) { const int blk = (t) >> 2; if (blk < P.own) { if (!((selbits >> blk) & 1u)) { const float NEG = -__builtin_inff(); _Pragma("unroll") for (int r = 0; r < 16; ++r) { p0[r] = NEG; p1[r] = NEG; } } } \
                                 else if (tb + 63 > qw) mask_tile(p0, p1, qw + r32 - tb - 4 * hi, 0x40000000u); } \
                float alpha; softmax_tile(p0, p1, m_reg, l_reg, alpha); \
                if (__any(alpha < 1.f)) { if (hi == 0) al_l[r32] = alpha; asm volatile("s_waitcnt lgkmcnt(0)" ::: "memory"); \
                    _Pragma("unroll") for (int r = 0; r < 16; ++r) { const float a_ = al_l[crow(r, hi)]; o[0][r] *= a_; o[1][r] *= a_; o[2][r] *= a_; o[3][r] *= a_; } } } \
            pack_p(p0, p1, pa0, pa1, pa2, pa3); SBAR(); pv_tile<B>(o, vb0, pa0, pa1, pa2, pa3); } \
        if (more) TWRITE((B) ^ 1); \
        if (MODE == 3 && lane == 0) flags[(B) * 8 + wid] = done ? 1u : 0u; \
        __syncthreads(); } while (0)
    for (int t = 0; t < NT; t += 2) {
        STEP(t, 0);
        if (MODE == 3) { unsigned f = 1u; _Pragma("unroll") for (int w = 0; w < 8; ++w) f &= flags[w]; if (f) break; }
        if (t + 1 < NT) { STEP(t + 1, 1);
            if (MODE == 3) { unsigned f = 1u; _Pragma("unroll") for (int w = 0; w < 8; ++w) f &= flags[8 + w]; if (f) break; } }
    }
#undef STEP
#undef TLOAD
#undef TWRITE
    float rli[16];
    if (MODE != 3) { if (hi == 0) li_l[r32] = l_reg; asm volatile("s_waitcnt lgkmcnt(0)" ::: "memory");
#pragma unroll
        for (int r = 0; r < 16; ++r) rli[r] = __builtin_amdgcn_rcpf(li_l[crow(r, hi)]); }
    if (MODE == 0 && CO_FP8) {
#pragma unroll
        for (int r = 0; r < 16; ++r) { const int qi = qw + crow(r, hi); unsigned char* orow = (unsigned char*)O + (size_t)(qi * stride + res) * opitch;
#pragma unroll
            for (int d0 = 0; d0 < 4; ++d0) { const float a = o[d0][r] * rli[r], b = xor_lane<1>(a), a2 = xor_lane<2>(a), b2 = xor_lane<2>(b);
                if ((r32 & 3) == 0) *(unsigned*)(orow + d0 * 32 + r32) = pk4f8(a, b, a2, b2); } }
    } else {
#pragma unroll
    for (int r = 0; r < 16; ++r) { const int qi = qw + crow(r, hi); bf16* orow = O + (size_t)(qi * stride + res) * opitch;
#pragma unroll
        for (int d0 = 0; d0 < 4; ++d0) { const float v = MODE != 3 ? o[d0][r] * rli[r] : o[d0][r]; const float vn = xor_lane<1>(v);
            if ((r32 & 1) == 0) *(unsigned*)(orow + d0 * 32 + r32) = cvtpk(v, vn); } }
    }
    if (MODE == 1 && hi == 0) L[(size_t)((qw + r32) * stride + res) * 2] = m_reg + lg2(l_reg);
    asm volatile("s_waitcnt lgkmcnt(0)" ::: "memory"); __builtin_amdgcn_s_barrier();
}

#if MOBA_GATHER
constexpr int RES_WS = 133120;
__device__ __forceinline__ void moba_gates(LAS char* lds, const bf16* Qh, const float* kmp, const int qb, unsigned* sel, unsigned short* list, unsigned* cnt, const int wid) {
    const int lane_ = lane_id();
    const int lane = lane_, tid = wid * 64 + lane, r32 = lane & 31, hi = lane >> 5;
    LAS char* K_lds = lds + OFF_K; LAS unsigned* cw = (LAS unsigned*)(lds + OFF_WS);
    const int qw = qb * 256 + wid * 32, sc = (tid & 15) * 8;
    bf16x8 qr[8];
    { const bf16* qp = Qh + (size_t)(qw + r32) * HD + hi * 8;
#pragma unroll
      for (int d0 = 0; d0 < 8; ++d0) qr[d0] = *(const bf16x8*)(qp + d0 * 16); }
    { const int row = tid >> 4, blk = row & 15, lo = row >> 4; const float* km = kmp + (size_t)blk * 2 * HD + sc; float v[8];
#pragma unroll
      for (int i = 0; i < 8; ++i) { v[i] = (km[i] + km[HD + i]) * (1.f / 256.f); const float h = __uint_as_float(f2bf(v[i]) << 16); v[i] = lo ? v[i] - h : h; }
      u32x4 w; w.x = pk2(v[0], v[1]); w.y = pk2(v[2], v[3]); w.z = pk2(v[4], v[5]); w.w = pk2(v[6], v[7]);
      *(LAS u32x4*)(K_lds + kswz(row, sc * 2)) = w; }
    __syncthreads();
    unsigned selbits = 0u;
    { f32x16 g0, g1; qkt<0, false>(g0, g1, K_lds, r32, hi, qr);
      float gown[8], goth[8];
#pragma unroll
      for (int r = 0; r < 8; ++r) { gown[r] = g0[r] + g0[r + 8]; goth[r] = get_xor32(gown[r], hi); }
      float g16[16];
#pragma unroll
      for (int a = 0; a < 2; ++a)
#pragma unroll
          for (int h2 = 0; h2 < 2; ++h2)
#pragma unroll
              for (int i = 0; i < 4; ++i) { const int blk = 8 * a + 4 * h2 + i; const float v = (h2 == hi) ? gown[4 * a + i] : goth[4 * a + i]; g16[blk] = blk < qb ? v : -__builtin_inff(); }
#pragma unroll
      for (int rk = 0; rk < 3; ++rk) { float best = -__builtin_inff(); int bi = -1;
#pragma unroll
          for (int j = 0; j < 16; ++j) if (g16[j] > best) { best = g16[j]; bi = j; }
#pragma unroll
          for (int j = 0; j < 16; ++j) if (j == bi) g16[j] = -__builtin_inff();
          if (bi >= 0) selbits |= 1u << bi; } }
    const bool mine = hi == 0;
    if (mine) sel[qw + r32] = selbits;
#pragma unroll 1
    for (int j = 0; j < 16; ++j) { const unsigned long long m = __ballot(mine && ((selbits >> j) & 1u)); if (lane == 0) cw[wid * 16 + j] = (unsigned)__popcll(m); }
    __syncthreads();
#pragma unroll 1
    for (int j = 0; j < 16; ++j) { const bool bit = mine && ((selbits >> j) & 1u); const unsigned long long m = __ballot(bit); unsigned base = 0u;
#pragma unroll
        for (int w = 0; w < 8; ++w) base += w < wid ? cw[w * 16 + j] : 0u;
        if (bit) list[(size_t)(j * 16 + qb) * 256 + base + (unsigned)__popcll(m & ((1ull << r32) - 1ull))] = (unsigned short)(qw + r32); }
    if (wid == 0 && lane < 16) { unsigned t = 0u;
#pragma unroll
        for (int w = 0; w < 8; ++w) t += cw[w * 16 + lane];
        cnt[lane * 16 + qb] = t; }
    __syncthreads();
}
__device__ __forceinline__ void moba_unit(LAS char* lds, const bf16* Qh, const bf16* Kh, const bf16* Vh, const int j, const int k, const unsigned* cnt, const unsigned short* list, const unsigned* sel, bf16* P0, float* L0, const int wid) {
    const int lane_ = lane_id();
    const int lane = lane_, tid = wid * 64 + lane, r32 = lane & 31, hi = lane >> 5;
    const int cv = (lane > j && lane < 16) ? (int)cnt[lane] : 0;
    int total = 0;
#pragma unroll
    for (int q = 1; q < 16; ++q) total += __builtin_amdgcn_readlane(cv, q);
    const int nch = total > 512 ? (total + 511) >> 9 : 1;
    if (k >= nch) { asm volatile("s_waitcnt lgkmcnt(0)" ::: "memory"); __builtin_amdgcn_s_barrier(); return; }
    LAS char* K_lds = lds + 4 * SHM;
    { const int sr = tid >> 4, sc = (tid & 15) * 8, vst0 = v_st(sr, sc), vst1 = v_st(32 + sr, sc), kws = kswz(sr, sc * 2);
      const size_t a0 = (size_t)(256 * j + sr) * HD + sc; bf16x8 kk[4][2], vv[4][2];
#pragma unroll
      for (int t = 0; t < 4; ++t) { kk[t][0] = *(const bf16x8*)(Kh + a0 + (size_t)(64 * t) * HD); kk[t][1] = *(const bf16x8*)(Kh + a0 + (size_t)(64 * t + 32) * HD);
          vv[t][0] = *(const bf16x8*)(Vh + a0 + (size_t)(64 * t) * HD); vv[t][1] = *(const bf16x8*)(Vh + a0 + (size_t)(64 * t + 32) * HD); }
#pragma unroll
      for (int t = 0; t < 4; ++t) { *(LAS bf16x8*)(K_lds + t * SHM + kws) = kk[t][0]; *(LAS bf16x8*)(K_lds + t * SHM + kws + 32 * 256) = kk[t][1];
          *(LAS bf16x8*)(lds + t * SHM + vst0) = vv[t][0]; *(LAS bf16x8*)(lds + t * SHM + vst1) = vv[t][1]; } }
    __syncthreads();
    const unsigned vb0 = (unsigned)(size_t)lds + v_rd_base(lane);
    LAS unsigned* rinfo = (LAS unsigned*)(lds + RES_WS) + wid * 128; LAS float* li_l = (LAS float*)(rinfo + 32); LAS float* al_l = li_l + 32;
    const int lo = k << 9, rem = total - lo, nl = rem < 0 ? 0 : (rem < 512 ? rem : 512), ngl = (nl + 31) >> 5, ng = ngl + (k == nch - 1 ? 8 : 0);
#define LOOKUP(G, SROW, VALID) do { if ((G) < ngl) { const int p_ = ((G) << 5) + r32, pp_ = lo + p_; VALID = p_ < nl; int acc_ = 0, seg_ = 0, off_ = 0; \
            _Pragma("unroll") for (int q = 1; q < 16; ++q) { const int c_ = __builtin_amdgcn_readlane(cv, q); if (pp_ >= acc_ && pp_ < acc_ + c_) { seg_ = q; off_ = pp_ - acc_; } acc_ += c_; } \
            SROW = VALID ? (int)list[seg_ * 256 + off_] : 256 * j; } \
        else { SROW = 256 * j + ((G) - ngl) * 32 + r32; VALID = true; } } while (0)
#define QLOAD(SROW) do { const bf16* qp_ = Qh + (size_t)(SROW) * HD + hi * 8; _Pragma("unroll") for (int d0 = 0; d0 < 8; ++d0) qr[d0] = *(const bf16x8*)(qp_ + d0 * 16); } while (0)
    int g = wid, srow = 256 * j; bool valid = false; unsigned selw = 0u; bf16x8 qr[8];
    if (g < ng) { LOOKUP(g, srow, valid); selw = sel[srow]; QLOAD(srow); }
#pragma unroll 1
    while (g < ng) {
        const bool ownq = g >= ngl; const int qo = (g - ngl) * 32, gn = g + 8;
        int srow_n = 256 * j; bool valid_n = false; unsigned selw_n = 0u;
        if (gn < ng) LOOKUP(gn, srow_n, valid_n);
        float m_reg = -1e30f, l_reg = 0.f; f32x16 o[4];
        { float z = 0.f; asm volatile("" : "+v"(z));
#pragma unroll
          for (int r = 0; r < 16; ++r) { o[0][r] = z; o[1][r] = z; o[2][r] = z; o[3][r] = z; } }
#define RTAIL(B) do { bf16x8 pa0, pa1, pa2, pa3; \
                if (ownq && 64 * (B) + 63 > qo) mask_tile(p0, p1, qo + r32 - 64 * (B) - 4 * hi, 0x40000000u); \
                float alpha; softmax_tile(p0, p1, m_reg, l_reg, alpha); \
                if ((B) > 0 && __any(alpha < 1.f)) { if (hi == 0) al_l[r32] = alpha; asm volatile("s_waitcnt lgkmcnt(0)" ::: "memory"); \
                    _Pragma("unroll") for (int r = 0; r < 16; ++r) { const float a_ = al_l[crow(r, hi)]; o[0][r] *= a_; o[1][r] *= a_; o[2][r] *= a_; o[3][r] *= a_; } } \
                pack_p(p0, p1, pa0, pa1, pa2, pa3); SBAR(); pv_tile<B>(o, vb0, pa0, pa1, pa2, pa3); } while (0)
#define RTILE(B) do { if (!ownq || (64 * (B) <= qo + 31)) { f32x16 p0, p1; qkt<B, true>(p0, p1, K_lds, r32, hi, qr); RTAIL(B); } } while (0)
        RTILE(0); RTILE(1); RTILE(2);
        { const bool act3 = !ownq || (192 <= qo + 31); f32x16 p0, p1;
          if (act3) qkt<3, true>(p0, p1, K_lds, r32, hi, qr);
          const unsigned info = (unsigned)srow | ((ownq ? 3u : (unsigned)__popc(selw & ((1u << j) - 1u))) << 16) | ((valid ? 1u : 0u) << 20);
          if (hi == 0) rinfo[r32] = info;
          if (gn < ng) { selw_n = sel[srow_n]; QLOAD(srow_n); }
          if (act3) RTAIL(3);
          if (hi == 0) li_l[r32] = l_reg; asm volatile("s_waitcnt lgkmcnt(0)" ::: "memory");
#pragma unroll
          for (int r = 0; r < 16; ++r) { const int rr = crow(r, hi); const unsigned inf = rinfo[rr]; const float rl = __builtin_amdgcn_rcpf(li_l[rr]); const bool ok = ((inf >> 20) & 1u) != 0u;
              bf16* orow = P0 + (size_t)((inf >> 16) & 15u) * ((size_t)M * 512) + (size_t)(inf & 0xffffu) * 512;
#pragma unroll
              for (int d0 = 0; d0 < 4; ++d0) { const float v = o[d0][r] * rl; const float vn = xor_lane<1>(v); if (ok && (r32 & 1) == 0) *(unsigned*)(orow + d0 * 32 + r32) = cvtpk(v, vn); } }
          if (hi == 0 && valid) { L0[((size_t)((info >> 16) & 15u) * M + srow) * 4] = m_reg + lg2(l_reg);
              if (ownq) { for (int sl = j; sl < 3; ++sl) L0[((size_t)sl * M + srow) * 4] = -__builtin_inff(); } } }
#undef RTILE
#undef RTAIL
        g = gn; srow = srow_n; valid = valid_n; selw = selw_n;
    }
#undef LOOKUP
#undef QLOAD
    asm volatile("s_waitcnt lgkmcnt(0)" ::: "memory"); __builtin_amdgcn_s_barrier();
}
#endif
}

__device__ __forceinline__ void fast_attention(Frame& F, unsigned* qctr, const int n_ckv) {
    const bf16 *Q = (const bf16*)(F.ws + WS_Q), *K = (const bf16*)(F.ws + WS_K), *V = (const bf16*)(F.ws + WS_V);
    bf16 *OA = (bf16*)(F.ws + WS_OA), *OB = (bf16*)(F.ws + WS_OB), *OC = (bf16*)(F.ws + WS_OC); float* LSE = (float*)(F.ws + WS_LSE); const float* KMP = (const float*)(F.ws + WS_KMP);
    LAS char* lds = (LAS char*)F.lds; volatile LAS unsigned* slot = (volatile LAS unsigned*)(lds + att::OFF_SLOT);
    unsigned nxt = 0u;
    if (F.wave == 0 && lane_id() == 0) nxt = __hip_atomic_fetch_add(qctr, 1u, __ATOMIC_RELAXED, __HIP_MEMORY_SCOPE_AGENT);
    for (;;) {
        if (F.wave == 0 && lane_id() == 0) *slot = nxt;
        asm volatile("s_waitcnt lgkmcnt(0)" ::: "memory"); __builtin_amdgcn_s_barrier();
        const int uq = (int)__builtin_amdgcn_readfirstlane(*slot);
        if (F.wave == 0 && lane_id() == 0) nxt = __hip_atomic_fetch_add(qctr, 1u, __ATOMIC_RELAXED, __HIP_MEMORY_SCOPE_AGENT);
        if (uq < n_ckv) { pg8::Gemm g{(const bf16*)(F.ws + WS_MEMN), (const bf16*)(F.ws + WS_WCKV), MROWS, DEPTH * 2 * CW, DM}; pg8::OneUnit S{uq & 3, uq >> 2};
            pg8::EpiOut<2> E{nullptr, (bf16*)(F.ws + WS_CK), 1.f, (WS_CV - WS_CK) / 2};
            pg8::gemm_phase<pg8::EpiOut<2>, pg8::OneUnit, true, true>(F.lds, g, S, E, F.wave); __syncthreads(); continue; }
#if MOBA_GATHER
        int u = uq - n_ckv;
        constexpr int NMOBA = 65 * 16;
        if (u >= NMOBA + 768) break;
        if (u < NMOBA) { int r = u >> 4, k = 0, nj = 16; const int bh = u & 15, b = bh >> 2, h = bh & 3; const size_t hb = (size_t)(b * 16 + h) * SEQ * HD;
            while (r >= nj) { r -= nj; ++k; nj = 15 - 2 * k; }
            const int j = r;
            att::moba_unit(lds, Q + hb, K + hb, V + hb, j, k, (const unsigned*)(F.ws + WS_CNT) + (bh * 16 + j) * 16, (const unsigned short*)(F.ws + WS_LIST) + (size_t)(bh * 16 + j) * 16 * 256,
                           (const unsigned*)(F.ws + WS_SEL) + bh * SEQ, (bf16*)(F.ws + WS_PART) + (size_t)b * SEQ * 512 + h * HD, (float*)(F.ws + WS_PLSE) + (size_t)b * SEQ * 4 + h, F.wave);
            continue; }
        u -= NMOBA - 256;
        if (false) {}
#else
        const int u = uq - n_ckv;
        if (u >= 1024) break;
        if (u < 256) { const int own = 15 - (u >> 4), bh = u & 15, b = bh >> 2, h = bh & 3; const size_t hb = (size_t)(b * 16 + h) * SEQ * HD;
            att::attn_unit<2>(lds, Q + hb, K + hb, V + hb, 1, 0, own * 256, att::PolMoba{own}, OA + (size_t)b * SEQ * 512 + h * HD, 512, nullptr, KMP + (size_t)bh * 16 * 2 * HD, F.wave); }
#endif
        else if (u < 640) { const int v = u - 256, bh6 = v % 24, qb = 15 - v / 24, b = bh6 / 6, h = 4 + bh6 % 6; const size_t hb = (size_t)(b * 16 + h) * SEQ * HD;
            att::attn_unit<3>(lds, Q + hb, K + hb, V + hb, 1, 0, qb * 256, att::PolSB{qb * 256}, OB + (size_t)b * SEQ * 768 + (h - 4) * HD, 768, nullptr, nullptr, F.wave); }
        else { const int v = u - 640, bh6 = v % 24, idx = v / 24, b = bh6 / 6, hc = bh6 % 6, g = hc >> 1, jj = hc & 1, sh = 2 * g, d = 1 << sh, nqb = 16 >> sh, res = idx / nqb, qi0 = (idx % nqb) * 256;
            const size_t hb = (size_t)(b * 16 + 10 + hc) * SEQ * HD; const int tb0 = qi0 >= 128 ? qi0 - 128 : 0;
            att::attn_unit<1>(lds, Q + hb, K + hb, V + hb, d, res, qi0, att::PolDil{tb0, (qi0 + 256 - tb0) >> 6}, OC + ((size_t)g * M + (size_t)b * SEQ) * 256 + jj * HD, 256, LSE + ((size_t)g * M + (size_t)b * SEQ) * 2 + jj, nullptr, F.wave); }
    }
}
#if MOBA_GATHER
static_assert(OUT_I8, "the MoBA partial merge lives in the int8 branch of phase_merge");
__device__ __forceinline__ void phase_gates(Frame& F) {
    const bf16* Q = (const bf16*)(F.ws + WS_Q); const float* KMP = (const float*)(F.ws + WS_KMP);
    for (int u = blockIdx.x; u < 256; u += gridDim.x) { const int bh = u >> 4, qb = u & 15, b = bh >> 2, h = bh & 3;
        att::moba_gates((LAS char*)F.lds, Q + (size_t)(b * 16 + h) * SEQ * HD, KMP + (size_t)bh * 16 * 2 * HD, qb, (unsigned*)(F.ws + WS_SEL) + bh * SEQ,
                        (unsigned short*)(F.ws + WS_LIST) + (size_t)bh * 16 * 16 * 256, (unsigned*)(F.ws + WS_CNT) + bh * 256, F.wave); }
}
#endif
__device__ __forceinline__ void fast_xattn(Frame& F, int layer) {
    const bf16 *QC = (const bf16*)(F.ws + WS_QC), *CK = (const bf16*)(F.ws + WS_CK), *CV = (const bf16*)(F.ws + WS_CV); bf16* OCR = (bf16*)(F.ws + WS_OCR);
    for (int u = blockIdx.x; u < 256; u += gridDim.x) { const int bh = u >> 4, qb = u & 15, b = bh >> 2, h = bh & 3; const size_t kb = ((size_t)(layer * 4 + b) * 4 + h) * MEML * HD;
        att::attn_unit<0>((LAS char*)F.lds, QC + (size_t)bh * SEQ * HD, CK + kb, CV + kb, 1, 0, qb * 256, att::PolCross{}, CO_FP8 ? (bf16*)((unsigned char*)OCR + (size_t)b * SEQ * CW + h * HD) : OCR + (size_t)b * SEQ * CW + h * HD, CW, nullptr, nullptr, F.wave); }
}

#define XB_TMO      128
#define XB_XCNT(j)  (256  + 64 * (j))
#define XB_XSUB(j)  (1280 + 64 * (j))
#define XB_XGEN(j)  (2304 + 64 * (j))
#define XB_TOP      3328
#define XB_TOPGEN   3392
#define XCD_BAR_WORDS 3456
#define XB_SPIN_CAP (1u << 18)

__device__ __forceinline__ unsigned xb_ld(unsigned* p)              { return __hip_atomic_load(p, __ATOMIC_RELAXED, __HIP_MEMORY_SCOPE_AGENT); }
__device__ __forceinline__ unsigned xb_add(unsigned* p, unsigned v) { return __hip_atomic_fetch_add(p, v, __ATOMIC_RELAXED, __HIP_MEMORY_SCOPE_AGENT); }
__device__ __forceinline__ unsigned xb_xcc_id() { return (unsigned)__builtin_amdgcn_s_getreg((3 << 11) | 20) & 0xFu; }
#define XB_SPIN(cond, bar) do { unsigned _sp = 0; while (cond) { __builtin_amdgcn_s_sleep(1); \
    if ((++_sp & 255u) == 0u) { if (xb_ld(&(bar)[XB_TMO])) break; if (_sp > XB_SPIN_CAP) { atomicAdd(&(bar)[XB_TMO], 1u); break; } } } } while (0)

struct XcdBarrier {
    unsigned* bar; unsigned x;
    volatile LAS unsigned* st;
};

__device__ __forceinline__ XcdBarrier xcd_barrier_post(unsigned* bar, volatile LAS unsigned* st) {
    XcdBarrier b; b.bar = bar; b.x = xb_xcc_id(); b.st = st;
    if (threadIdx.x == 0) (void)xb_add(&bar[XB_XCNT(b.x)], 1u);
    return b;
}
__device__ __forceinline__ void xcd_barrier_complete(unsigned* bar, unsigned x, unsigned& nloc, unsigned& nx) {
    const unsigned G = gridDim.x * gridDim.y * gridDim.z;
    unsigned sum, cnt, mine, sp = 0u;
    for (;;) {
        sum = 0u; cnt = 0u; mine = 0u;
#pragma unroll
        for (unsigned j = 0; j < 16; ++j) { const unsigned c = xb_ld(&bar[XB_XCNT(j)]); sum += c; cnt += (c > 0u) ? 1u : 0u; mine = (j == x) ? c : mine; }
        if (sum == G) break;
        __builtin_amdgcn_s_sleep(1);
        if ((++sp & 255u) == 0u) { if (xb_ld(&bar[XB_TMO])) break; if (sp > XB_SPIN_CAP) { atomicAdd(&bar[XB_TMO], 1u); break; } }
    }
    nloc = mine > 0u ? mine : 1u; nx = cnt > 0u ? cnt : 1u;
}

__device__ __forceinline__ void xcd_barrier(const XcdBarrier& b) {
    asm volatile("s_waitcnt vmcnt(0)" ::: "memory");
    __syncthreads();
    if (threadIdx.x == 0) {
        unsigned* bar = b.bar;
        __builtin_amdgcn_s_waitcnt(0);
        unsigned nloc = b.st[0], nx = b.st[1];
        if (nloc == 0u) { xcd_barrier_complete(bar, b.x, nloc, nx); b.st[0] = nloc; b.st[1] = nx; }
        const unsigned old = xb_add(&bar[XB_XSUB(b.x)], 1u);
        const unsigned gen = old / nloc;
        if (old + 1u == (gen + 1u) * nloc) {
            __builtin_amdgcn_fence(__ATOMIC_RELEASE, "agent");
            asm volatile("s_waitcnt vmcnt(0)" ::: "memory");
            const unsigned og = xb_add(&bar[XB_TOP], 1u);
            const unsigned tg = og / nx;
            if (og + 1u == (tg + 1u) * nx) xb_add(&bar[XB_TOPGEN], 1u);
            else XB_SPIN(xb_ld(&bar[XB_TOPGEN]) == tg, bar);
            __builtin_amdgcn_fence(__ATOMIC_ACQUIRE, "agent");
            xb_add(&bar[XB_XGEN(b.x)], 1u);
            asm volatile("s_waitcnt vmcnt(0)" ::: "memory");
        } else {
            XB_SPIN(xb_ld(&bar[XB_XGEN(b.x)]) == gen, bar);
            __builtin_amdgcn_fence(__ATOMIC_ACQUIRE, "agent");
            asm volatile("s_waitcnt vmcnt(0)" ::: "memory");
        }
    }
    __syncthreads();
}

#ifndef MK_ONE_LAUNCH
#define MK_ONE_LAUNCH 1
#endif
#ifndef FAST_QKV
#define FAST_QKV 1
#endif
#ifndef FAST_RES
#define FAST_RES 1
#endif
#ifndef FAST_CQ
#define FAST_CQ 1
#endif
#ifndef FAST_UP
#define FAST_UP 1
#endif
#ifndef FAST_CKV
#define FAST_CKV 1
#endif
#ifndef FAST_ATT
#define FAST_ATT 1
#endif
#ifndef FAST_XATT
#define FAST_XATT 1
#endif
__global__ void __launch_bounds__(NTHREADS, 2) mk_fwd(Args args) {
    extern __shared__ __attribute__((aligned(16))) unsigned char lds[];
    Frame F; F.lds = (LAS unsigned char*)lds; F.lane = threadIdx.x & 63; F.wave = __builtin_amdgcn_readfirstlane(threadIdx.x >> 6);
    F.gw = blockIdx.x * NWAVES + F.wave; F.ngw = gridDim.x * NWAVES; F.X = args.out; F.ws = args.ws;
    const int lo = args.ph_lo, hi = args.ph_hi;
    volatile LAS unsigned* MISC = (volatile LAS unsigned*)(F.lds + MISC_OFF);
    for (int u = threadIdx.x; u < 64; u += NTHREADS) MISC[u] = 0u;
    __syncthreads();
    XcdBarrier bar; bar.bar = (unsigned*)(args.ws + WS_CTL) + CW_BAR; bar.x = 0; bar.st = nullptr;
    if (hi - lo > 1) bar = xcd_barrier_post((unsigned*)(args.ws + WS_CTL) + CW_BAR, MISC + 8);
#define IN(k) (lo <= (k) && (k) < hi)
#define SEAM(k) do { if (IN(k) && (k) + 1 < hi) xcd_barrier(bar); } while (0)
#define ENTER() do { F.lane = lane_id(); } while (0)
    unsigned char* ws = args.ws;
    const float* ssp = (const float*)(ws + WS_SSP);
    if (IN(PH_PRO0)) phase_pro0(F, args);
    SEAM(PH_PRO0);
#define BFP(off) ((bf16*)(ws + (off)))
    if (IN(PH_PRO1) && !(FAST_CKV && FAST_ATT)) {
#if FAST_CKV
        pg8::Gemm g{BFP(WS_MEMN), BFP(WS_WCKV), MROWS, DEPTH * 2 * CW, DM}; pg8::StaticOrder S; S.init(MROWS, DEPTH * 2 * CW, (int)gridDim.x, (int)blockIdx.x);
        pg8::EpiOut<2> E{nullptr, BFP(WS_CK), 1.f, (WS_CV - WS_CK) / 2};
        pg8::gemm_phase<pg8::EpiOut<2>, pg8::StaticOrder, true, true>(F.lds, g, S, E, F.wave);
#else
        NEpiCkv E{BFP(WS_CK)}; ngemm(F, BFP(WS_MEMN), BFP(WS_WCKV), MROWS, DEPTH * 2 * CW, DM, E);
#endif
    }
    if (!(FAST_CKV && FAST_ATT)) SEAM(PH_PRO1);
    for (int l = 0; l < DEPTH; ++l) {
        const int pb = PH_L0 + PH_PER_LAYER * l;
        if (IN(pb + LP_QKV)) {
#if FAST_QKV
            { pg8::Gemm g{BFP(WS_XB), BFP(WS_WIN) + (size_t)l * NQKV * DM, M, V_FP8 ? 2 * DM : NQKV, DM}; pg8::StaticOrder S; S.init(M, V_FP8 ? 2 * DM : NQKV, (int)gridDim.x, (int)blockIdx.x);
              pg8::rstd_table(F.lds, ssp, S, F.wave);
              pg8::EpiQKV E{(const LAS float*)(F.lds + pg8::RTAB_OFF), (const float*)(ws + WS_ROPE), (const float*)(ws + WS_ROPE) + SEQ * 64, BFP(WS_Q), (WS_K - WS_Q) / 2, (float*)(ws + WS_KMP), C2, 0, 1.f};
              pg8::gemm_phase<pg8::EpiQKV, pg8::StaticOrder, true, true>(F.lds, g, S, E, F.wave); }
#if MOBA_GATHER
        }
        SEAM(pb + LP_QKV);
        if (IN(pb + LP_KM)) { ENTER(); phase_gates(F);
#endif
#if V_FP8
            { pg8::Gemm g{BFP(WS_XB8), BFP(WS_WV8 + (size_t)l * DM * DM), M, DM, DM}; pg8::StaticOrder S; S.init(M, DM, (int)gridDim.x, (int)blockIdx.x);
              pg8::rstd_table(F.lds, ssp, S, F.wave);
              pg8::EpiQKV E{(const LAS float*)(F.lds + pg8::RTAB_OFF), (const float*)(ws + WS_ROPE), (const float*)(ws + WS_ROPE) + SEQ * 64, BFP(WS_Q), (WS_K - WS_Q) / 2, (float*)(ws + WS_KMP), C2, 2, 1.f / W8_V_SCALE};
              pg8::gemm_phase<pg8::EpiQKV, pg8::StaticOrder, true, true, true>(F.lds, g, S, E, F.wave); }
#endif
#else
            NEpiQKV E{ssp, (const float*)(ws + WS_ROPE), (const float*)(ws + WS_ROPE) + SEQ * 64, BFP(WS_Q)};
            ngemm(F, BFP(WS_XB), BFP(WS_WIN) + (size_t)l * NQKV * DM, M, NQKV, DM, E);
#endif
        }
#if MOBA_GATHER
        SEAM(pb + LP_KM);
#else
        SEAM(pb + LP_QKV);
#endif
#if !FAST_QKV
        if (IN(pb + LP_KM)) { ENTER(); naive_kmean(F); }
        SEAM(pb + LP_KM);
#endif
        if (IN(pb + LP_ATT)) { ENTER();
#if FAST_ATT
            fast_attention(F, (unsigned*)(ws + WS_CTL) + 64 * (1 + l), (FAST_CKV && l == 0) ? (MROWS / 256) * (DEPTH * 2 * CW / 256) : 0);
#else
            naive_attention(F);
#endif
        }
        SEAM(pb + LP_ATT);
        if (IN(pb + LP_MRG)) { ENTER(); phase_merge(F); }
        SEAM(pb + LP_MRG);
        if (IN(pb + LP_OUT)) {
#if FAST_RES
            pg8::Gemm g{BFP(WS_MRG), OUT_I8 ? BFP(WS_WOUT + (size_t)l * DM * OW) : BFP(WS_WOUT) + (size_t)l * DM * OW, M, DM, OW}; pg8::StaticOrder S; S.init(M, DM, (int)gridDim.x, (int)blockIdx.x);
#if OUT_I8
            pg8::EpiResI8<CQ_FP8 != 0> E{BFP(WS_XB), (float*)(ws + WS_SSP), (const float*)(ws + WS_CSC) + l * DM};
            pg8::gemm_phase<pg8::EpiResI8<CQ_FP8 != 0>, pg8::StaticOrder, true, true, 2>(F.lds, g, S, E, F.wave);
#else
            pg8::EpiRes<1, CQ_FP8 != 0> E{BFP(WS_XB), (float*)(ws + WS_SSP)};
            pg8::gemm_phase<pg8::EpiRes<1, CQ_FP8 != 0>, pg8::StaticOrder, true, true>(F.lds, g, S, E, F.wave);
#endif
#else
            NEpiRes E{l == 0 ? args.in[0] : F.X, F.X, BFP(WS_XB), (float*)(ws + WS_SSP)}; ngemm(F, BFP(WS_MRG), BFP(WS_WOUT) + (size_t)l * DM * OW, M, DM, OW, E);
#endif
        }
        SEAM(pb + LP_OUT);
        if (IN(pb + LP_CQ)) {
#if FAST_CQ && CQ_FP8
            pg8::Gemm g{BFP(WS_XB8), BFP(WS_WCQ + (size_t)l * CW * DM), M, CW, DM}; pg8::StaticOrder S; S.init(M, CW, (int)gridDim.x, (int)blockIdx.x);
            pg8::rstd_table(F.lds, ssp, S, F.wave);
            pg8::EpiOut<0> E{(const LAS float*)(F.lds + pg8::RTAB_OFF), BFP(WS_QC), C2 / W8_CQ_SCALE, 0};
            pg8::gemm_phase<pg8::EpiOut<0>, pg8::StaticOrder, true, true, true>(F.lds, g, S, E, F.wave);
#elif FAST_CQ
            pg8::Gemm g{BFP(WS_XB), BFP(WS_WCQ) + (size_t)l * CW * DM, M, CW, DM}; pg8::StaticOrder S; S.init(M, CW, (int)gridDim.x, (int)blockIdx.x);
            pg8::rstd_table(F.lds, ssp, S, F.wave);
            pg8::EpiOut<0> E{(const LAS float*)(F.lds + pg8::RTAB_OFF), BFP(WS_QC), C2, 0};
            pg8::gemm_phase<pg8::EpiOut<0>, pg8::StaticOrder, true, true>(F.lds, g, S, E, F.wave);
#else
            NEpiCq E{ssp, BFP(WS_QC)}; ngemm(F, BFP(WS_XB), BFP(WS_WCQ) + (size_t)l * CW * DM, M, CW, DM, E);
#endif
        }
        SEAM(pb + LP_CQ);
        if (IN(pb + LP_XATT)) { ENTER();
#if FAST_XATT
            fast_xattn(F, l);
#else
            naive_xattn(F, l);
#endif
        }
        SEAM(pb + LP_XATT);
        if (IN(pb + LP_CO)) {
#if FAST_RES && CO_FP8
            pg8::Gemm g{BFP(WS_OCR), BFP(WS_WCO + (size_t)l * DM * CW), M, DM, CW}; pg8::StaticOrder S; S.init(M, DM, (int)gridDim.x, (int)blockIdx.x);
            pg8::EpiRes<32, MLP_FP8 != 0> E{BFP(WS_XB), (float*)(ws + WS_SSP)};
            pg8::gemm_phase<pg8::EpiRes<32, MLP_FP8 != 0>, pg8::StaticOrder, true, true, true>(F.lds, g, S, E, F.wave);
#elif FAST_RES
            pg8::Gemm g{BFP(WS_OCR), BFP(WS_WCO) + (size_t)l * DM * CW, M, DM, CW}; pg8::StaticOrder S; S.init(M, DM, (int)gridDim.x, (int)blockIdx.x);
            pg8::EpiRes<1, MLP_FP8 != 0> E{BFP(WS_XB), (float*)(ws + WS_SSP)};
            pg8::gemm_phase<pg8::EpiRes<1, MLP_FP8 != 0>, pg8::StaticOrder, true, true>(F.lds, g, S, E, F.wave);
#else
            NEpiRes E{F.X, F.X, BFP(WS_XB), (float*)(ws + WS_SSP)}; ngemm(F, BFP(WS_OCR), BFP(WS_WCO) + (size_t)l * DM * CW, M, DM, CW, E);
#endif
        }
        SEAM(pb + LP_CO);
        if (IN(pb + LP_UP)) {
#if FAST_UP && MLP_FP8
            pg8::Gemm g{BFP(WS_XB8), BFP(WS_WUP + (size_t)l * FF * DM), M, FF, DM}; pg8::StaticOrder S; S.init(M, FF, (int)gridDim.x, (int)blockIdx.x);
            pg8::rstd_table(F.lds, ssp, S, F.wave);
            pg8::EpiOut<3> E{(const LAS float*)(F.lds + pg8::RTAB_OFF), BFP(WS_ACT), 1.f / W8_UP_SCALE, 0};
            pg8::gemm_phase<pg8::EpiOut<3>, pg8::StaticOrder, true, true, true>(F.lds, g, S, E, F.wave);
#elif FAST_UP
            pg8::Gemm g{BFP(WS_XB), BFP(WS_WUP) + (size_t)l * FF * DM, M, FF, DM}; pg8::StaticOrder S; S.init(M, FF, (int)gridDim.x, (int)blockIdx.x);
            pg8::rstd_table(F.lds, ssp, S, F.wave);
            pg8::EpiOut<1> E{(const LAS float*)(F.lds + pg8::RTAB_OFF), BFP(WS_ACT), 1.f, 0};
            pg8::gemm_phase<pg8::EpiOut<1>, pg8::StaticOrder, true, true>(F.lds, g, S, E, F.wave);
#else
            NEpiUp E{ssp, BFP(WS_ACT)}; ngemm(F, BFP(WS_XB), BFP(WS_WUP) + (size_t)l * FF * DM, M, FF, DM, E);
#endif
        }
        SEAM(pb + LP_UP);
        if (IN(pb + LP_DN)) {
#if FAST_RES && MLP_FP8
            pg8::Gemm g{BFP(WS_ACT), BFP(WS_WDN + (size_t)l * DM * FF), M, DM, FF}; pg8::StaticOrder S; S.init(M, DM, (int)gridDim.x, (int)blockIdx.x);
            pg8::EpiRes<128, V_FP8 != 0> E{BFP(WS_XB), (float*)(ws + WS_SSP)};
            pg8::gemm_phase<pg8::EpiRes<128, V_FP8 != 0>, pg8::StaticOrder, true, true, true>(F.lds, g, S, E, F.wave);
#elif FAST_RES
            pg8::Gemm g{BFP(WS_ACT), BFP(WS_WDN) + (size_t)l * DM * FF, M, DM, FF}; pg8::StaticOrder S; S.init(M, DM, (int)gridDim.x, (int)blockIdx.x);
            pg8::EpiRes<1, false> E{BFP(WS_XB), (float*)(ws + WS_SSP)};
            pg8::gemm_phase<pg8::EpiRes<1, false>, pg8::StaticOrder, true, true>(F.lds, g, S, E, F.wave);
#else
            NEpiRes E{F.X, F.X, BFP(WS_XB), (float*)(ws + WS_SSP)}; ngemm(F, BFP(WS_ACT), BFP(WS_WDN) + (size_t)l * DM * FF, M, DM, FF, E);
#endif
        }
        SEAM(pb + LP_DN);
    }
    if (IN(PH_FINAL)) { ENTER(); phase_final(F, args.in[16]); }
#undef IN
}

extern "C" void kernel_launch(void* const* d_in, const int* in_sizes, int n_in, void* d_out, int out_size, void* d_ws, size_t ws_size, hipStream_t stream) {
    static int grid = 0;
    if (grid == 0) {
        if (n_in != 17 || out_size != M * DM || ws_size < WS_END) { fprintf(stderr, "kernel_launch: unexpected shapes (n_in %d out %d ws %zu)\n", n_in, out_size, ws_size); grid = -1; return; }
        int dev = 0, cus = 0;
        if (hipGetDevice(&dev) != hipSuccess || hipDeviceGetAttribute(&cus, hipDeviceAttributeMultiprocessorCount, dev) != hipSuccess) { grid = -1; return; }
        if (hipFuncSetAttribute((const void*)mk_fwd, hipFuncAttributeMaxDynamicSharedMemorySize, LDS_BYTES) != hipSuccess) { grid = -1; return; }
        if (cus < 256) { fprintf(stderr, "kernel_launch: built for a 256-CU device (one resident workgroup per CU, 8 GEMM units per workgroup at most); found %d CUs, nothing launched\n", cus); grid = -1; return; }
        grid = 256;
    }
    if (grid < 0) return;
    (void)hipMemsetAsync((char*)d_ws + WS_CTL, 0, CTL_ZERO_BYTES, stream);
    Args a{};
    for (int i = 0; i < 17; ++i) a.in[i] = (const float*)d_in[i];
    a.out = (float*)d_out; a.ws = (unsigned char*)d_ws;
#if MK_ONE_LAUNCH
    a.ph_lo = 0; a.ph_hi = NPH; hipLaunchKernelGGL(mk_fwd, dim3(grid), dim3(NTHREADS), LDS_BYTES, stream, a);
#else
    for (int ph = 0; ph < NPH; ++ph) { a.ph_lo = ph; a.ph_hi = ph + 1; hipLaunchKernelGGL(mk_fwd, dim3(grid), dim3(NTHREADS), LDS_BYTES, stream, a); }
#endif
}
```
